# Optimizing an MI355X kernel written in HIP

```python
import math
import jax, jax.numpy as jnp
from jax import lax
import numpy as np

D_MODEL = 2048
BATCH = 8
SEQ = 4096
DEPTH = 2

D_MIX = D_MODEL
D_A = D_MIX // 2
D_B = D_MIX - D_A
A_GROUPS = 16
B_HEADS = 16
B_HEAD_DIM = D_B // B_HEADS
CONV_A_WIDTH = 3
CONV_B_WIDTH = 4
LRU_C = 8.0
D_IN_EVEN = 3 * D_A + 2 * D_B
SB_HEADS = 16
SB_HEAD_DIM = D_MODEL // SB_HEADS
Q_BLOCK = 128
D_FF = 4 * D_MODEL
NORM_EPS = 1e-6
N_EVEN = (DEPTH + 1) // 2
N_ODD = DEPTH // 2

kernel_name = "hybrid_conv_rglru_stickbreak_block"


def rms_norm(x, g):
    xf = x.astype(jnp.float32)
    y = xf * lax.rsqrt(jnp.mean(xf * xf, axis=-1, keepdims=True) + NORM_EPS)
    return (y * g.astype(jnp.float32)).astype(x.dtype)


def causal_dwconv(x, w, bias=None):
    k_width = w.shape[0]
    s = x.shape[1]
    xp = jnp.pad(x, ((0, 0), (k_width - 1, 0), (0, 0)))
    y = w[k_width - 1] * x
    for k in range(k_width - 1):
        y = y + w[k] * xp[:, k:k + s]
    if bias is not None:
        y = y + bias
    return y


def rg_lru(x, w_a, b_a, w_x, b_x, lam):
    bsz, s, _ = x.shape
    xf = x.astype(jnp.float32)
    xh = xf.reshape(bsz, s, B_HEADS, B_HEAD_DIM)
    r = jax.nn.sigmoid(jnp.einsum('bshi,hij->bshj', xh, w_a.astype(jnp.float32)).reshape(bsz, s, D_B)
                       + b_a.astype(jnp.float32))
    i = jax.nn.sigmoid(jnp.einsum('bshi,hij->bshj', xh, w_x.astype(jnp.float32)).reshape(bsz, s, D_B)
                       + b_x.astype(jnp.float32))
    log_a = LRU_C * r * jax.nn.log_sigmoid(lam.astype(jnp.float32))
    a = jnp.exp(log_a)
    mult = jnp.sqrt(-jnp.expm1(2.0 * log_a))
    b = mult * (i * xf)

    def combine(e1, e2):
        a1, b1 = e1
        a2, b2 = e2
        return a1 * a2, a2 * b1 + b2

    _, h = lax.associative_scan(combine, (a, b), axis=1)
    return h.astype(x.dtype)


def conv_lru_mixer(h, w_in, conv_a, conv_b, conv_b_bias, rg_w_a, rg_b_a, rg_w_x, rg_b_x, rg_lambda, w_out):
    proj = h @ w_in
    a_bgate, a_cgate, a_x, b_gate, b_x = jnp.split(
        proj, [D_A, 2 * D_A, 3 * D_A, 3 * D_A + D_B], axis=-1)
    y_a = a_bgate * causal_dwconv(a_cgate * a_x, conv_a)
    xr = causal_dwconv(b_x, conv_b, conv_b_bias)
    y_b = rg_lru(xr, rg_w_a, rg_b_a, rg_w_x, rg_b_x, rg_lambda) * jax.nn.gelu(b_gate, approximate=True)
    return jnp.concatenate([y_a, y_b], axis=-1) @ w_out


def stick_breaking_attention(h, w_qkv, w_o):
    bsz, s, _ = h.shape
    qkv = h @ w_qkv
    q, k, v = jnp.split(qkv, 3, axis=-1)
    to_heads = lambda t: t.reshape(bsz, s, SB_HEADS, SB_HEAD_DIM).transpose(0, 2, 1, 3)
    q, k, v = to_heads(q), to_heads(k), to_heads(v)
    n_blocks = s // Q_BLOCK
    q_blocks = q.reshape(bsz, SB_HEADS, n_blocks, Q_BLOCK, SB_HEAD_DIM).transpose(2, 0, 1, 3, 4)
    starts = jnp.arange(n_blocks, dtype=jnp.int32) * Q_BLOCK
    scale = 1.0 / math.sqrt(SB_HEAD_DIM)
    kf = k.astype(jnp.float32)
    vf = v.astype(jnp.float32)
    key_pos = jnp.arange(s, dtype=jnp.int32)[None, :]

    def block(args):
        q_blk, start = args
        z = jnp.einsum('bhqd,bhkd->bhqk', q_blk.astype(jnp.float32), kf) * scale
        q_pos = start + jnp.arange(Q_BLOCK, dtype=jnp.int32)[:, None]
        causal = key_pos < q_pos
        log_not = jnp.where(causal, jax.nn.log_sigmoid(-z), 0.0)
        suffix = lax.cumsum(log_not, axis=3, reverse=True) - log_not
        w = jnp.where(causal, jnp.exp(jax.nn.log_sigmoid(z) + suffix), 0.0)
        return jnp.einsum('bhqk,bhkd->bhqd', w, vf)

    out = lax.map(block, (q_blocks, starts))
    out = out.transpose(1, 0, 3, 2, 4).reshape(bsz, s, D_MODEL).astype(h.dtype)
    return out @ w_o


def sq_relu_mlp(h, w_up, w_down):
    u = jax.nn.relu(h @ w_up)
    return (u * u) @ w_down


def setup_inputs(seed: int = 0) -> dict:
    key = jax.random.key(seed)
    ks = jax.random.split(key, 20)
    nrm = lambda k, shape, fan_in: jax.random.normal(k, shape, jnp.float32) * (fan_in ** -0.5)
    x = jax.random.normal(ks[0], (BATCH, SEQ, D_MODEL), jnp.float32)
    norm_gains = 1.0 + 0.05 * jax.random.normal(ks[1], (DEPTH, 4, D_MODEL), jnp.float32)
    hyb_w_in = nrm(ks[2], (N_EVEN, D_MODEL, D_IN_EVEN), D_MODEL)
    hyb_conv_a = nrm(ks[3], (N_EVEN, CONV_A_WIDTH, D_A), CONV_A_WIDTH)
    hyb_conv_b = nrm(ks[4], (N_EVEN, CONV_B_WIDTH, D_B), CONV_B_WIDTH)
    hyb_conv_b_bias = 0.02 * jax.random.normal(ks[5], (N_EVEN, D_B), jnp.float32)
    hyb_rg_w_a = nrm(ks[6], (N_EVEN, B_HEADS, B_HEAD_DIM, B_HEAD_DIM), B_HEAD_DIM)
    hyb_rg_b_a = 0.02 * jax.random.normal(ks[7], (N_EVEN, D_B), jnp.float32)
    hyb_rg_w_x = nrm(ks[8], (N_EVEN, B_HEADS, B_HEAD_DIM, B_HEAD_DIM), B_HEAD_DIM)
    hyb_rg_b_x = 0.02 * jax.random.normal(ks[9], (N_EVEN, D_B), jnp.float32)
    u = jax.random.uniform(ks[10], (N_EVEN, D_B), jnp.float32, 0.9, 0.999)
    sig = u ** (1.0 / LRU_C)
    hyb_rg_lambda = jnp.log(sig) - jnp.log1p(-sig)
    hyb_w_out = nrm(ks[11], (N_EVEN, D_MIX, D_MODEL), D_MIX)
    sb_w_qkv = nrm(ks[12], (N_ODD, D_MODEL, 3 * D_MODEL), D_MODEL)
    sb_w_o = nrm(ks[13], (N_ODD, D_MODEL, D_MODEL), D_MODEL)
    mlp_w_up = nrm(ks[14], (DEPTH, D_MODEL, D_FF), D_MODEL)
    mlp_w_down = nrm(ks[15], (DEPTH, D_FF, D_MODEL), D_FF)
    return {"x": x, "norm_gains": norm_gains, "hyb_w_in": hyb_w_in, "hyb_conv_a": hyb_conv_a,
            "hyb_conv_b": hyb_conv_b, "hyb_conv_b_bias": hyb_conv_b_bias, "hyb_rg_w_a": hyb_rg_w_a,
            "hyb_rg_b_a": hyb_rg_b_a, "hyb_rg_w_x": hyb_rg_w_x, "hyb_rg_b_x": hyb_rg_b_x,
            "hyb_rg_lambda": hyb_rg_lambda, "hyb_w_out": hyb_w_out, "sb_w_qkv": sb_w_qkv,
            "sb_w_o": sb_w_o, "mlp_w_up": mlp_w_up, "mlp_w_down": mlp_w_down}


def reference(x, norm_gains, hyb_w_in, hyb_conv_a, hyb_conv_b, hyb_conv_b_bias, hyb_rg_w_a, hyb_rg_b_a,
              hyb_rg_w_x, hyb_rg_b_x, hyb_rg_lambda, hyb_w_out, sb_w_qkv, sb_w_o, mlp_w_up, mlp_w_down):
    for layer in range(DEPTH):
        g = norm_gains[layer]
        h = rms_norm(x, g[0])
        if layer % 2 == 0:
            e = layer // 2
            mix = conv_lru_mixer(h, hyb_w_in[e], hyb_conv_a[e], hyb_conv_b[e], hyb_conv_b_bias[e],
                                 hyb_rg_w_a[e], hyb_rg_b_a[e], hyb_rg_w_x[e], hyb_rg_b_x[e],
                                 hyb_rg_lambda[e], hyb_w_out[e])
        else:
            o = layer // 2
            mix = stick_breaking_attention(h, sb_w_qkv[o], sb_w_o[o])
        x = x + rms_norm(mix, g[1])
        h = rms_norm(x, g[2])
        x = x + rms_norm(sq_relu_mlp(h, mlp_w_up[layer], mlp_w_down[layer]), g[3])
    return x
```

```cpp
#include <hip/hip_runtime.h>
#include <hip/hip_cooperative_groups.h>
#include <cstdio>
#include <cstdint>
namespace cg = cooperative_groups;
namespace pg8 {
#define PG8_LAS __attribute__((address_space(3)))
typedef unsigned short bf16_t;
typedef short bf16x8 __attribute__((ext_vector_type(8)));
typedef float f32x4 __attribute__((ext_vector_type(4)));
typedef unsigned u32x4 __attribute__((ext_vector_type(4)));
constexpr int BM = 256, BK = 64, HALF = 128, HTB = HALF * BK * 2  , STAGE_BYTES = 8 * HTB, NXCD = 8, WGM = 8;

__host__ __device__ __forceinline__ int lds_byte(int r, int c) { const int st = (r >> 4) * 2 + (c >> 5), rr = r & 15, cc = c & 31, ob = rr * 64 + cc * 2; return st * 1024 + (ob ^ (((ob >> 9) & 1) << 5)); }
__host__ __device__ __forceinline__ void stage_rc(int b, int& R, int& C) { const int st = b / 1024, sb = b % 1024, swz = sb ^ (((sb >> 9) & 1) << 5); R = (st >> 1) * 16 + swz / 64; C = (st & 1) * 32 + (swz % 64) / 2; }
__host__ __device__ __forceinline__ int perm32(int rho) { const int n = rho >> 4, i = rho & 15; return 8 * (i >> 2) + 4 * n + (i & 3); }

struct Unit { int pm, pn; };
struct Gemm { const bf16_t* A; const bf16_t* Bt; int M, N, K; };

struct StaticOrder {
    int nM, nN, nwg, G, c;
    __host__ __device__ void init(int M, int N, int G_, int c_) { nM = M / BM; nN = N / BM; nwg = nM * nN; G = G_; c = c_; }
    __host__ __device__ bool next(int i, Unit& u) const {
        const long L = (long)i * G + c; if (L >= nwg) return false;
        int wgid = (int)L; { const int q = nwg / NXCD, r = nwg % NXCD, xcd = wgid % NXCD, off = wgid / NXCD; wgid = (xcd < r ? xcd * (q + 1) : r * (q + 1) + (xcd - r) * q) + off; }
        const int nig = WGM * nN, gid = wgid / nig, fm = gid * WGM, gsz = (nM - fm) < WGM ? (nM - fm) : WGM;
        u.pm = fm + ((wgid % nig) % gsz); u.pn = (wgid % nig) / gsz; return true;
    }
    __device__ __forceinline__ void a_ready(const Unit&) const {}
    __device__ __forceinline__ void done(const Unit&) const {}
};
__device__ __forceinline__ unsigned cvt_pk_bf16(float lo, float hi) { unsigned r; asm volatile("v_cvt_pk_bf16_f32 %0, %1, %2" : "=v"(r) : "v"(lo), "v"(hi)); return r; }
typedef float f32x2 __attribute__((ext_vector_type(2)));
__device__ __forceinline__ unsigned short f2bf1(float f) { unsigned u = __builtin_bit_cast(unsigned, f); return (unsigned short)((u + 0x7fffu + ((u >> 16) & 1u)) >> 16); }

struct EpiGen {
    static constexpr bool PERM = true, AFTER_DRAIN = false;
    int mode; bf16_t* O; int ldc; bf16_t* K; bf16_t* Vt; float qscale; const float* rowscale;
    __device__ __forceinline__ void operator()(const f32x4 (&acc)[2][2][4][2], const Unit& u, int wr, int wc, int fr, int fq) const {
        const int t3 = u.pn >> 3;
        if (mode == 3 && t3 == 2) {
            const int cv0 = (u.pn - 16) * BM + wc * 32 + 8 * fq;
#pragma unroll
            for (int ai = 0; ai < 2; ++ai)
#pragma unroll
                for (int m = 0; m < 4; ++m) { const int r = u.pm * BM + ai * HALF + wr * 64 + m * 16 + fr; const int b = r >> 12, t = r & 4095; const float rsv = rowscale ? rowscale[r] : 1.f;
#pragma unroll
                    for (int bj = 0; bj < 2; ++bj)
#pragma unroll
                        for (int n = 0; n < 2; ++n)
#pragma unroll
                            for (int e = 0; e < 4; ++e) { const int cv = cv0 + bj * HALF + 4 * n + e; const int head = cv >> 7, d = cv & 127;
                                Vt[((size_t)((b * 16 + head) * 128 + d) << 12) + t] = f2bf1(acc[ai][bj][m][n][e] * rsv); } }
            return;
        }
        bf16_t* base = O; float sc = 1.f; int colt = u.pn * BM;
        if (mode == 3) { colt = (u.pn & 7) * BM; if (t3) base = K; else sc = qscale; }
        const bool sq = (mode == 2);
        const int row0 = u.pm * BM + wr * 64 + fr; const int col0 = colt + wc * 32 + 8 * fq;
#pragma unroll
        for (int ai = 0; ai < 2; ++ai)
#pragma unroll
            for (int m = 0; m < 4; ++m) { bf16_t* rowp = base + (size_t)(row0 + ai * HALF + m * 16) * ldc + col0; const float rsc = (rowscale ? rowscale[row0 + ai * HALF + m * 16] : 1.f) * sc;
#pragma unroll
                for (int bj = 0; bj < 2; ++bj) { f32x4 v0 = acc[ai][bj][m][0] * rsc, v1 = acc[ai][bj][m][1] * rsc;
                    if (sq) {
#pragma unroll
                        for (int e = 0; e < 4; ++e) { float a = v0[e] > 0.f ? v0[e] : 0.f; v0[e] = a * a; float b = v1[e] > 0.f ? v1[e] : 0.f; v1[e] = b * b; } }
                    u32x4 w; w.x = cvt_pk_bf16(v0[0], v0[1]); w.y = cvt_pk_bf16(v0[2], v0[3]); w.z = cvt_pk_bf16(v1[0], v1[1]); w.w = cvt_pk_bf16(v1[2], v1[3]);
                    *(u32x4*)(rowp + bj * HALF) = w; } }
    }
};

template <class Epi, class Sched, bool ALIGN_EPI = false, bool SP2 = false>
__device__ __forceinline__ void gemm_phase(PG8_LAS unsigned char* lds, const Gemm g, const Sched& S, const Epi& E) {
    int tid = threadIdx.x; asm volatile("" : "+v"(tid)); const int wid = __builtin_amdgcn_readfirstlane(tid >> 6), lane = tid & 63, wr = wid >> 2, wc = wid & 3, fr = lane & 15, fq = lane >> 4;
    const int K = g.K, nt = K / BK;
    unsigned voffA[2], voffB[2];
#pragma unroll
    for (int i = 0; i < 2; ++i) { int R, C; stage_rc(tid * 16 + i * 8192, R, C); const int Rb = Epi::PERM ? ((R & ~31) + perm32(R & 31)) : R;
        voffA[i] = (unsigned)(R * K + C) * 2u; voffB[i] = (unsigned)(Rb * K + C) * 2u; }
    const size_t kstep = (size_t)(BK * 2);
    const size_t hstep = (size_t)HALF * K * 2;
    const size_t tstep = 2 * hstep;
    const unsigned ldsw = (unsigned)wid * 1024u;
    const int aoff = lds_byte(wr * 64 + fr, fq * 8), boff = lds_byte(wc * 32 + fr, fq * 8);
#define PG8_SA(b, h) (((b) * 2 + (h)) * HTB)
#define PG8_SB(b, h) ((4 + (b) * 2 + (h)) * HTB)
#define PG8_STAGE(bufoff, gbase, voff) do { _Pragma("unroll") for (int _i = 0; _i < 2; ++_i) \
        __builtin_amdgcn_global_load_lds((const unsigned*)((const char*)(gbase) + (voff)[_i]), (PG8_LAS unsigned*)(lds + (bufoff) + ldsw + _i * 8192), 16, 0, 0); } while (0)
#define PG8_LDA(dst, b, h) do { _Pragma("unroll") for (int m = 0; m < 4; ++m) _Pragma("unroll") for (int k = 0; k < 2; ++k) dst[m][k] = *(const PG8_LAS bf16x8*)(lds + PG8_SA(b, h) + aoff + m * 2048 + k * 1024); } while (0)
#define PG8_LDB(dst, b, h) do { _Pragma("unroll") for (int n = 0; n < 2; ++n) _Pragma("unroll") for (int k = 0; k < 2; ++k) dst[n][k] = *(const PG8_LAS bf16x8*)(lds + PG8_SB(b, h) + boff + n * 2048 + k * 1024); } while (0)
#define PG8_MMA(ai, bj, At, Bt) do { __builtin_amdgcn_s_setprio(1); _Pragma("unroll") for (int m = 0; m < 4; ++m) _Pragma("unroll") for (int n = 0; n < 2; ++n) _Pragma("unroll") for (int k = 0; k < 2; ++k) \
        acc[ai][bj][m][n] = __builtin_amdgcn_mfma_f32_16x16x32_bf16(Bt[n][k], At[m][k], acc[ai][bj][m][n], 0, 0, 0); __builtin_amdgcn_s_setprio(0); } while (0)
#define PG8_WAIT_V(n) asm volatile("s_waitcnt vmcnt(" #n ")" ::: "memory")
#define PG8_WAIT_L(n) asm volatile("s_waitcnt lgkmcnt(" #n ")" ::: "memory")
#define PG8_BAR __builtin_amdgcn_s_barrier()
#define PG8_SCHED __builtin_amdgcn_sched_barrier(0)
    Unit cur, nxt; int ui = 0;
    if (!S.next(0, cur)) return;
    f32x4 acc[2][2][4][2];
#pragma unroll
    for (int a = 0; a < 2; ++a)
#pragma unroll
        for (int b = 0; b < 2; ++b)
#pragma unroll
            for (int m = 0; m < 4; ++m)
#pragma unroll
                for (int n = 0; n < 2; ++n) acc[a][b][m][n] = (f32x4){0.f, 0.f, 0.f, 0.f};
    bf16x8 At[4][2], B0[2][2], B1[2][2];
    const char* cA = (const char*)g.A + (size_t)cur.pm * tstep; const char* cB = (const char*)g.Bt + (size_t)cur.pn * tstep;
    S.a_ready(cur);
    if constexpr (SP2) {
        PG8_STAGE(PG8_SB(0, 0), cB, voffB); PG8_STAGE(PG8_SB(0, 1), cB + hstep, voffB); PG8_STAGE(PG8_SA(0, 0), cA, voffA); PG8_STAGE(PG8_SA(0, 1), cA + hstep, voffA);
        if (wr == 1) PG8_BAR;
        PG8_WAIT_V(2); PG8_BAR;
        PG8_STAGE(PG8_SB(1, 0), cB + kstep, voffB); PG8_STAGE(PG8_SA(1, 0), cA + kstep, voffA); PG8_STAGE(PG8_SB(1, 1), cB + hstep + kstep, voffB);
        PG8_WAIT_V(6); PG8_BAR;
    } else {
        PG8_STAGE(PG8_SB(0, 0), cB, voffB); PG8_STAGE(PG8_SA(0, 0), cA, voffA); PG8_STAGE(PG8_SB(0, 1), cB + hstep, voffB); PG8_STAGE(PG8_SA(0, 1), cA + hstep, voffA);
        if (wr == 1) PG8_BAR;
        PG8_WAIT_V(4); PG8_BAR;
        PG8_STAGE(PG8_SB(1, 0), cB + kstep, voffB); PG8_STAGE(PG8_SA(1, 0), cA + kstep, voffA); PG8_STAGE(PG8_SB(1, 1), cB + hstep + kstep, voffB);
        PG8_WAIT_V(6); PG8_BAR;
    }
    for (;;) {
        const bool has_next = S.next(ui + 1, nxt);
        const char* nA = has_next ? (const char*)g.A + (size_t)nxt.pm * tstep : cA; const char* nB = has_next ? (const char*)g.Bt + (size_t)nxt.pn * tstep : cB;
        for (int t = 0; t < nt; t += 2) {
            const bool last = (t == nt - 2);
            const char* a1 = cA + (size_t)(t + 1) * kstep;
            const char* a2 = last ? nA : cA + (size_t)(t + 2) * kstep; const char* b2 = last ? nB : cB + (size_t)(t + 2) * kstep;
            const char* a3 = a2 + kstep; const char* b3 = b2 + kstep;
            if (last && has_next) S.a_ready(nxt);
            if constexpr (SP2) {
            PG8_LDB(B0, 0, 0); PG8_LDB(B1, 0, 1); PG8_SCHED; PG8_LDA(At, 0, 0); PG8_STAGE(PG8_SA(1, 1), a1 + hstep, voffA);
            PG8_WAIT_V(8); PG8_WAIT_L(0); PG8_BAR; PG8_MMA(0, 0, At, B0); PG8_MMA(0, 1, At, B1); PG8_BAR; PG8_SCHED;
            PG8_LDA(At, 0, 1); PG8_STAGE(PG8_SB(0, 0), b2, voffB); PG8_STAGE(PG8_SB(0, 1), b2 + hstep, voffB); PG8_STAGE(PG8_SA(0, 0), a2, voffA);
            PG8_WAIT_V(8); PG8_WAIT_L(0); PG8_BAR; PG8_MMA(1, 0, At, B0); PG8_MMA(1, 1, At, B1); PG8_BAR; PG8_SCHED;
            PG8_LDB(B0, 1, 0); PG8_LDB(B1, 1, 1); PG8_SCHED; PG8_LDA(At, 1, 0); PG8_STAGE(PG8_SA(0, 1), a2 + hstep, voffA);
            PG8_WAIT_V(8); PG8_WAIT_L(0); PG8_BAR; PG8_MMA(0, 0, At, B0); PG8_MMA(0, 1, At, B1); PG8_BAR; PG8_SCHED;
            PG8_LDA(At, 1, 1); PG8_STAGE(PG8_SB(1, 0), b3, voffB); PG8_STAGE(PG8_SB(1, 1), b3 + hstep, voffB); PG8_STAGE(PG8_SA(1, 0), a3, voffA);
            PG8_WAIT_V(8); PG8_WAIT_L(0); PG8_BAR; PG8_MMA(1, 0, At, B0); PG8_MMA(1, 1, At, B1); PG8_BAR; PG8_SCHED;
            } else {
            PG8_LDB(B0, 0, 0); PG8_SCHED; PG8_LDA(At, 0, 0); PG8_STAGE(PG8_SA(1, 1), a1 + hstep, voffA);
            PG8_WAIT_L(8); PG8_BAR; PG8_WAIT_L(0); PG8_MMA(0, 0, At, B0); PG8_BAR; PG8_SCHED;
            PG8_LDB(B1, 0, 1); PG8_STAGE(PG8_SB(0, 0), b2, voffB);
            PG8_BAR; PG8_WAIT_L(0); PG8_MMA(0, 1, At, B1); PG8_BAR;
            PG8_LDA(At, 0, 1); PG8_STAGE(PG8_SA(0, 0), a2, voffA);
            PG8_BAR; PG8_WAIT_L(0); PG8_MMA(1, 0, At, B0); PG8_BAR; PG8_SCHED;
            PG8_STAGE(PG8_SB(0, 1), b2 + hstep, voffB);
            PG8_WAIT_V(6); PG8_BAR; PG8_MMA(1, 1, At, B1); PG8_BAR;
            PG8_LDB(B0, 1, 0); PG8_SCHED; PG8_LDA(At, 1, 0); PG8_STAGE(PG8_SA(0, 1), a2 + hstep, voffA);
            PG8_WAIT_L(8); PG8_BAR; PG8_WAIT_L(0); PG8_MMA(0, 0, At, B0); PG8_BAR; PG8_SCHED;
            PG8_LDB(B1, 1, 1); PG8_STAGE(PG8_SB(1, 0), b3, voffB);
            PG8_BAR; PG8_WAIT_L(0); PG8_MMA(0, 1, At, B1); PG8_BAR;
            PG8_LDA(At, 1, 1); PG8_STAGE(PG8_SA(1, 0), a3, voffA);
            PG8_BAR; PG8_WAIT_L(0); PG8_MMA(1, 0, At, B0); PG8_BAR; PG8_SCHED;
            PG8_STAGE(PG8_SB(1, 1), b3 + hstep, voffB);
            PG8_WAIT_V(6); PG8_BAR; PG8_MMA(1, 1, At, B1); PG8_BAR;
            }
        }
        if constexpr (ALIGN_EPI) { if (wr == 0) PG8_BAR; }
        if constexpr (!Epi::AFTER_DRAIN) { E(acc, cur, wr, wc, fr, fq); S.done(cur); }
        if (!has_next) break;
#pragma unroll
        for (int a = 0; a < 2; ++a)
#pragma unroll
            for (int b = 0; b < 2; ++b)
#pragma unroll
                for (int m = 0; m < 4; ++m)
#pragma unroll
                    for (int n = 0; n < 2; ++n) acc[a][b][m][n] = (f32x4){0.f, 0.f, 0.f, 0.f};
        cur = nxt; cA = nA; cB = nB; ++ui;
        if constexpr (ALIGN_EPI) { if (wr == 1) PG8_BAR; }
    }
    PG8_WAIT_V(0);
    if constexpr (!ALIGN_EPI) { if (wr == 0) PG8_BAR; }
    PG8_BAR;
    if constexpr (Epi::AFTER_DRAIN) { E.fused(acc, cur, wr, wc, fr, fq, lds, wid, lane); S.done(cur); }
#undef PG8_SA
#undef PG8_SB
#undef PG8_STAGE
#undef PG8_LDA
#undef PG8_LDB
#undef PG8_MMA
#undef PG8_WAIT_V
#undef PG8_WAIT_L
#undef PG8_BAR
#undef PG8_SCHED
}
}
#define LAS __attribute__((address_space(3)))
typedef unsigned short bf16;
typedef unsigned v4u __attribute__((ext_vector_type(4)));
typedef unsigned v2u __attribute__((ext_vector_type(2)));
typedef float f32x4 __attribute__((ext_vector_type(4)));
typedef float f32x16 __attribute__((ext_vector_type(16)));
typedef short bf16x8 __attribute__((ext_vector_type(8)));
constexpr int NWAVES = 8, NTHR = 512;
constexpr int BATCH = 8, SEQ = 4096, DM = 2048, MTOK = BATCH * SEQ, DIN = 5120, DFF = 8192, NQKV = 6144;
constexpr float NORM_EPS = 1e-6f;
constexpr size_t MiB = 1u << 20;
constexpr size_t WS_WIN = 0, WS_WOUT = 20 * MiB, WS_WQKV = 28 * MiB, WS_WO = 52 * MiB, WS_WUP0 = 60 * MiB, WS_WUP1 = 92 * MiB, WS_WDN0 = 124 * MiB, WS_WDN1 = 156 * MiB;
constexpr size_t WS_H = 192 * MiB, WS_MIX = 320 * MiB, WS_BIG = 448 * MiB, WS_CTL = 960 * MiB, CTL_BYTES = 16384, WS_RS = 960 * MiB + 65536, WS_END = 961 * MiB;
constexpr int LDS_MISC = 131072, LDS_BYTES = 131072 + 256;

__device__ __forceinline__ float bflo(unsigned u) { return __uint_as_float(u << 16); }
__device__ __forceinline__ float bfhi(unsigned u) { return __uint_as_float(u & 0xffff0000u); }
__device__ __forceinline__ unsigned pk2(float lo, float hi) { return pg8::cvt_pk_bf16(lo, hi); }
__device__ __forceinline__ float wave_sum(float v) {
#pragma unroll
    for (int o = 1; o < 64; o <<= 1) v += __shfl_xor(v, o);
    return v;
}
#define LDS_BARRIER() do { asm volatile("s_waitcnt lgkmcnt(0)" ::: "memory"); __builtin_amdgcn_s_barrier(); asm volatile("" ::: "memory"); } while (0)
__device__ __forceinline__ float fsigmoid(float x) { return __builtin_amdgcn_rcpf(1.f + __expf(-x)); }

__device__ __forceinline__ void p0_transpose_item(const float* W, int K, int N, bf16* WT, LAS float* scr, int item, int lane, const float* gk = nullptr) {
    const int nblk = N / 32, kb = item / nblk, nb = item % nblk, k0 = 64 * kb, n0 = 32 * nb;
    float tv[32];
#pragma unroll
    for (int i = 0; i < 32; ++i) tv[i] = W[(size_t)(k0 + 2 * i + (lane >> 5)) * N + n0 + (lane & 31)];
#pragma unroll
    for (int i = 0; i < 32; ++i) scr[(2 * i + (lane >> 5)) * 33 + (lane & 31)] = tv[i];
    asm volatile("s_waitcnt lgkmcnt(0)" ::: "memory");
    const int c = lane & 7;
    f32x4 g0 = {1.f, 1.f, 1.f, 1.f}, g1 = {1.f, 1.f, 1.f, 1.f};
    if (gk) { g0 = *(const f32x4*)(gk + k0 + 8 * c); g1 = *(const f32x4*)(gk + k0 + 8 * c + 4); }
#pragma unroll
    for (int j = 0; j < 4; ++j) { const int n = (lane >> 3) + 8 * j; const LAS float* s = scr + (8 * c) * 33 + n;
        v4u o; o.x = pk2(s[0 * 33] * g0.x, s[1 * 33] * g0.y); o.y = pk2(s[2 * 33] * g0.z, s[3 * 33] * g0.w); o.z = pk2(s[4 * 33] * g1.x, s[5 * 33] * g1.y); o.w = pk2(s[6 * 33] * g1.z, s[7 * 33] * g1.w);
        *(v4u*)(WT + (size_t)(n0 + n) * K + k0 + 8 * c) = o; }
    asm volatile("s_waitcnt lgkmcnt(0)" ::: "memory");
}

__device__ __forceinline__ void cvt_row(const float* xrow, bf16* orow, float* rs, int lane) {
    f32x4 v[4][2]; float ss = 0.f;
#pragma unroll
    for (int j = 0; j < 4; ++j)
#pragma unroll
        for (int e = 0; e < 2; ++e) { v[j][e] = *(const f32x4*)(xrow + 512 * j + 8 * lane + 4 * e); ss += (v[j][e].x * v[j][e].x + v[j][e].y * v[j][e].y) + (v[j][e].z * v[j][e].z + v[j][e].w * v[j][e].w); }
    const float r = __builtin_amdgcn_rsqf(wave_sum(ss) * (1.f / DM) + NORM_EPS);
#pragma unroll
    for (int j = 0; j < 4; ++j) { const f32x4 a = v[j][0], b = v[j][1];
        v4u o; o.x = pk2(a.x, a.y); o.y = pk2(a.z, a.w); o.z = pk2(b.x, b.y); o.w = pk2(b.z, b.w);
        *(v4u*)(orow + 512 * j + 8 * lane) = o; }
    if (lane == 0) *rs = r;
}

template <bool XIN_F32, bool OUT_F32>
__device__ __forceinline__ void post_row(const bf16* mrow, const float* xin_f, const bf16* xin_b, float* xout_f, bf16* xout_b, const float* gpost, float* rs, int lane) {
    f32x4 mv[4][2], xv[4][2], gp[4][2]; float ss = 0.f;
    v4u r[4], xr[4];
#pragma unroll
    for (int j = 0; j < 4; ++j) r[j] = *(const v4u*)(mrow + 512 * j + 8 * lane);
    if (XIN_F32) {
#pragma unroll
        for (int j = 0; j < 4; ++j)
#pragma unroll
            for (int e = 0; e < 2; ++e) xv[j][e] = *(const f32x4*)(xin_f + 512 * j + 8 * lane + 4 * e);
    } else {
#pragma unroll
        for (int j = 0; j < 4; ++j) xr[j] = *(const v4u*)(xin_b + 512 * j + 8 * lane);
#pragma unroll
        for (int j = 0; j < 4; ++j) { xv[j][0] = (f32x4){bflo(xr[j].x), bfhi(xr[j].x), bflo(xr[j].y), bfhi(xr[j].y)}; xv[j][1] = (f32x4){bflo(xr[j].z), bfhi(xr[j].z), bflo(xr[j].w), bfhi(xr[j].w)}; }
    }
#pragma unroll
    for (int j = 0; j < 4; ++j)
#pragma unroll
        for (int e = 0; e < 2; ++e) gp[j][e] = *(const f32x4*)(gpost + 512 * j + 8 * lane + 4 * e);
#pragma unroll
    for (int j = 0; j < 4; ++j) {
        mv[j][0] = (f32x4){bflo(r[j].x), bfhi(r[j].x), bflo(r[j].y), bfhi(r[j].y)}; mv[j][1] = (f32x4){bflo(r[j].z), bfhi(r[j].z), bflo(r[j].w), bfhi(r[j].w)};
#pragma unroll
        for (int e = 0; e < 2; ++e) ss += (mv[j][e].x * mv[j][e].x + mv[j][e].y * mv[j][e].y) + (mv[j][e].z * mv[j][e].z + mv[j][e].w * mv[j][e].w); }
    const float rs1 = __builtin_amdgcn_rsqf(wave_sum(ss) * (1.f / DM) + NORM_EPS);
    float s2 = 0.f;
#pragma unroll
    for (int j = 0; j < 4; ++j)
#pragma unroll
        for (int e = 0; e < 2; ++e) { const f32x4 x1 = xv[j][e] + mv[j][e] * rs1 * gp[j][e]; mv[j][e] = x1; s2 += (x1.x * x1.x + x1.y * x1.y) + (x1.z * x1.z + x1.w * x1.w); }
    if (OUT_F32) {
#pragma unroll
        for (int j = 0; j < 4; ++j)
#pragma unroll
            for (int e = 0; e < 2; ++e) *(f32x4*)(xout_f + 512 * j + 8 * lane + 4 * e) = mv[j][e];
    } else {
#pragma unroll
        for (int j = 0; j < 4; ++j) { const f32x4 a = mv[j][0], b = mv[j][1];
            v4u o; o.x = pk2(a.x, a.y); o.y = pk2(a.z, a.w); o.z = pk2(b.x, b.y); o.w = pk2(b.z, b.w);
            *(v4u*)(xout_b + 512 * j + 8 * lane) = o; }
        const float rs2 = __builtin_amdgcn_rsqf(wave_sum(s2) * (1.f / DM) + NORM_EPS);
        if (lane == 0) *rs = rs2;
    }
}

template <bool OUT_F32>
__device__ __forceinline__ void post_rows(const bf16* MIXb, bf16* XRb, float* outf, const float* gpost, float* RSb, int gw, int NGW, int lane) {
    f32x4 gp[4][2];
#pragma unroll
    for (int j = 0; j < 4; ++j)
#pragma unroll
        for (int e = 0; e < 2; ++e) gp[j][e] = *(const f32x4*)(gpost + 512 * j + 8 * lane + 4 * e);
    v4u nr[4], nx[4];
#pragma unroll
    for (int j = 0; j < 4; ++j) { nr[j] = *(const v4u*)(MIXb + (size_t)gw * DM + 512 * j + 8 * lane); nx[j] = *(const v4u*)(XRb + (size_t)gw * DM + 512 * j + 8 * lane); }
    for (int m = gw; m < MTOK; m += NGW) {
        v4u r[4], xr[4];
#pragma unroll
        for (int j = 0; j < 4; ++j) { r[j] = nr[j]; xr[j] = nx[j]; }
        const int mn = m + NGW;
        if (mn < MTOK) {
#pragma unroll
            for (int j = 0; j < 4; ++j) { nr[j] = *(const v4u*)(MIXb + (size_t)mn * DM + 512 * j + 8 * lane); nx[j] = *(const v4u*)(XRb + (size_t)mn * DM + 512 * j + 8 * lane); } }
        f32x4 mv[4][2]; float ss = 0.f;
#pragma unroll
        for (int j = 0; j < 4; ++j) {
            mv[j][0] = (f32x4){bflo(r[j].x), bfhi(r[j].x), bflo(r[j].y), bfhi(r[j].y)}; mv[j][1] = (f32x4){bflo(r[j].z), bfhi(r[j].z), bflo(r[j].w), bfhi(r[j].w)};
#pragma unroll
            for (int e = 0; e < 2; ++e) ss += (mv[j][e].x * mv[j][e].x + mv[j][e].y * mv[j][e].y) + (mv[j][e].z * mv[j][e].z + mv[j][e].w * mv[j][e].w); }
        const float rs1 = __builtin_amdgcn_rsqf(wave_sum(ss) * (1.f / DM) + NORM_EPS);
        float s2 = 0.f;
#pragma unroll
        for (int j = 0; j < 4; ++j) {
            const f32x4 x0 = (f32x4){bflo(xr[j].x), bfhi(xr[j].x), bflo(xr[j].y), bfhi(xr[j].y)}, x1 = (f32x4){bflo(xr[j].z), bfhi(xr[j].z), bflo(xr[j].w), bfhi(xr[j].w)};
            const f32x4 a = x0 + mv[j][0] * rs1 * gp[j][0], b = x1 + mv[j][1] * rs1 * gp[j][1]; mv[j][0] = a; mv[j][1] = b;
            s2 += ((a.x * a.x + a.y * a.y) + (a.z * a.z + a.w * a.w)) + ((b.x * b.x + b.y * b.y) + (b.z * b.z + b.w * b.w)); }
        if (OUT_F32) {
#pragma unroll
            for (int j = 0; j < 4; ++j)
#pragma unroll
                for (int e = 0; e < 2; ++e) *(f32x4*)(outf + (size_t)m * DM + 512 * j + 8 * lane + 4 * e) = mv[j][e];
        } else {
#pragma unroll
            for (int j = 0; j < 4; ++j) { const f32x4 a = mv[j][0], b = mv[j][1];
                v4u o; o.x = pk2(a.x, a.y); o.y = pk2(a.z, a.w); o.z = pk2(b.x, b.y); o.w = pk2(b.z, b.w);
                *(v4u*)(XRb + (size_t)m * DM + 512 * j + 8 * lane) = o; }
            const float rs2 = __builtin_amdgcn_rsqf(wave_sum(s2) * (1.f / DM) + NORM_EPS);
            if (lane == 0) RSb[m] = rs2;
        }
    }
}

__device__ __forceinline__ void cvt_rows(const float* x, bf16* XRb, float* RSb, int gw, int NGW, int lane) {
    f32x4 nv[4][2];
#pragma unroll
    for (int j = 0; j < 4; ++j)
#pragma unroll
        for (int e = 0; e < 2; ++e) nv[j][e] = *(const f32x4*)(x + (size_t)gw * DM + 512 * j + 8 * lane + 4 * e);
    for (int m = gw; m < MTOK; m += NGW) {
        f32x4 v[4][2]; float ss = 0.f;
#pragma unroll
        for (int j = 0; j < 4; ++j)
#pragma unroll
            for (int e = 0; e < 2; ++e) v[j][e] = nv[j][e];
        const int mn = m + NGW;
        if (mn < MTOK) {
#pragma unroll
            for (int j = 0; j < 4; ++j)
#pragma unroll
                for (int e = 0; e < 2; ++e) nv[j][e] = *(const f32x4*)(x + (size_t)mn * DM + 512 * j + 8 * lane + 4 * e); }
#pragma unroll
        for (int j = 0; j < 4; ++j)
#pragma unroll
            for (int e = 0; e < 2; ++e) ss += (v[j][e].x * v[j][e].x + v[j][e].y * v[j][e].y) + (v[j][e].z * v[j][e].z + v[j][e].w * v[j][e].w);
        const float r = __builtin_amdgcn_rsqf(wave_sum(ss) * (1.f / DM) + NORM_EPS);
#pragma unroll
        for (int j = 0; j < 4; ++j) { const f32x4 a = v[j][0], b = v[j][1];
            v4u o; o.x = pk2(a.x, a.y); o.y = pk2(a.z, a.w); o.z = pk2(b.x, b.y); o.w = pk2(b.z, b.w);
            *(v4u*)(XRb + (size_t)m * DM + 512 * j + 8 * lane) = o; }
        if (lane == 0) RSb[m] = r;
    }
}

__device__ __forceinline__ void mixerA_item(const bf16* proj, const float* conv_a, bf16* Y, int item, int tid) {
    const int cgp = tid & 127, tg = tid >> 7, c0 = 8 * cgp;
    const int row0 = item * 64 + tg * 16, t0 = row0 & (SEQ - 1);
    float w0[8], w1[8], w2[8], u1[8], u2[8];
#pragma unroll
    for (int e = 0; e < 8; ++e) { w0[e] = conv_a[c0 + e]; w1[e] = conv_a[1024 + c0 + e]; w2[e] = conv_a[2048 + c0 + e]; u1[e] = 0.f; u2[e] = 0.f; }
    if (t0 != 0) {
        const v4u c2 = *(const v4u*)(proj + (size_t)(row0 - 2) * DIN + 1024 + c0), x2 = *(const v4u*)(proj + (size_t)(row0 - 2) * DIN + 2048 + c0);
        const v4u c1 = *(const v4u*)(proj + (size_t)(row0 - 1) * DIN + 1024 + c0), x1 = *(const v4u*)(proj + (size_t)(row0 - 1) * DIN + 2048 + c0);
#pragma unroll
        for (int q = 0; q < 4; ++q) { u2[2 * q] = bflo(c2[q]) * bflo(x2[q]); u2[2 * q + 1] = bfhi(c2[q]) * bfhi(x2[q]); u1[2 * q] = bflo(c1[q]) * bflo(x1[q]); u1[2 * q + 1] = bfhi(c1[q]) * bfhi(x1[q]); }
    }
    for (int i0 = 0; i0 < 16; i0 += 4) {
        v4u bg[4], cgv[4], ax[4];
#pragma unroll
        for (int i = 0; i < 4; ++i) { const bf16* p = proj + (size_t)(row0 + i0 + i) * DIN + c0; bg[i] = *(const v4u*)p; cgv[i] = *(const v4u*)(p + 1024); ax[i] = *(const v4u*)(p + 2048); }
#pragma unroll
        for (int i = 0; i < 4; ++i) {
            float u0[8], y[8];
#pragma unroll
            for (int q = 0; q < 4; ++q) { u0[2 * q] = bflo(cgv[i][q]) * bflo(ax[i][q]); u0[2 * q + 1] = bfhi(cgv[i][q]) * bfhi(ax[i][q]); }
#pragma unroll
            for (int q = 0; q < 4; ++q) { y[2 * q] = bflo(bg[i][q]) * (w0[2 * q] * u2[2 * q] + w1[2 * q] * u1[2 * q] + w2[2 * q] * u0[2 * q]);
                y[2 * q + 1] = bfhi(bg[i][q]) * (w0[2 * q + 1] * u2[2 * q + 1] + w1[2 * q + 1] * u1[2 * q + 1] + w2[2 * q + 1] * u0[2 * q + 1]); }
            v4u o; o.x = pk2(y[0], y[1]); o.y = pk2(y[2], y[3]); o.z = pk2(y[4], y[5]); o.w = pk2(y[6], y[7]);
            *(v4u*)(Y + (size_t)(row0 + i0 + i) * DM + c0) = o;
#pragma unroll
            for (int e = 0; e < 8; ++e) { u2[e] = u1[e]; u1[e] = u0[e]; }
        }
    }
}

template <int SHR> __device__ __forceinline__ float dpp_shr(float oldv, float src) {
    return __builtin_bit_cast(float, __builtin_amdgcn_update_dpp(__builtin_bit_cast(int, oldv), __builtin_bit_cast(int, src), 0x110 + SHR, 0xf, 0xf, false));
}
template <int SHR> __device__ __forceinline__ void scan_step(float (&av)[16], float (&bv)[16]) {
#pragma unroll
    for (int i = 0; i < 16; ++i) { const float ap = dpp_shr<SHR>(1.f, av[i]); const float bp = dpp_shr<SHR>(0.f, bv[i]); bv[i] = av[i] * bp + bv[i]; av[i] = av[i] * ap; }
}
__device__ __forceinline__ void mixerB_item(const bf16* proj, const float* conv_b, const float* conv_b_bias, const float* w_a, const float* b_a, const float* w_x, const float* b_x,
                                            const float* lam, bf16* Y, int item, LAS unsigned char* lds, int tid) {
    const int b = item >> 4, hd = item & 15;
    const int lane = tid & 63, w = __builtin_amdgcn_readfirstlane(tid >> 6), fr = lane & 15, fq = lane >> 4;
    LAS float* cst = (LAS float*)lds;
    LAS float* agg = cst + 512;
    __syncthreads();
    { const int k = tid >> 6, c = tid & 63, ch = hd * 64 + c; float v;
      if (k < 4) v = conv_b[k * 1024 + ch]; else if (k == 4) v = conv_b_bias[ch]; else if (k == 5) v = b_a[ch]; else if (k == 6) v = b_x[ch];
      else { const float l = lam[ch]; v = 8.f * (fminf(l, 0.f) - log1pf(__expf(-fabsf(l)))); }
      cst[k * 64 + c] = v; }
    LAS unsigned char* wf = lds + 10240;
    {
#pragma unroll
        for (int q = 0; q < 2; ++q) { const int fi = w * 2 + q, mat = fi >> 3, mt = (fi >> 1) & 3, s = fi & 1; const float* wsrc = mat ? w_x : w_a; bf16x8 fragv;
#pragma unroll
            for (int jj = 0; jj < 8; ++jj) { const int idx = 8 * s + jj; const int i = 16 * (idx >> 2) + 4 * fq + (idx & 3); const int j = 16 * mt + fr;
                fragv[jj] = (short)pg8::f2bf1(wsrc[(size_t)(hd * 64 + i) * 64 + j]); }
            *(LAS bf16x8*)(wf + fi * 1024 + lane * 16) = fragv; }
    }
    __syncthreads();
    float hc[16];
#pragma unroll
    for (int i = 0; i < 16; ++i) hc[i] = 0.f;
    const bf16* pbx = proj + (size_t)(b * SEQ) * DIN + 4096 + hd * 64 + 4 * fq;
    const bf16* pgt = proj + (size_t)(b * SEQ) * DIN + 3072 + hd * 64 + 4 * fq;
    bf16* py = Y + (size_t)(b * SEQ) * DM + 1024 + hd * 64 + 4 * fq;
    v2u nraw[4][4], ngraw[4];
#define MB_LOAD(cc) do { const int t_ = (cc) * 128 + w * 16 + fr; _Pragma("unroll") for (int k = 0; k < 4; ++k) { const int tok = t_ - 3 + k; \
        _Pragma("unroll") for (int g = 0; g < 4; ++g) { nraw[k][g] = (v2u){0u, 0u}; if (tok >= 0) nraw[k][g] = *(const v2u*)(pbx + (size_t)tok * DIN + 16 * g); } } \
        _Pragma("unroll") for (int g = 0; g < 4; ++g) ngraw[g] = *(const v2u*)(pgt + (size_t)t_ * DIN + 16 * g); } while (0)
    MB_LOAD(0);
    for (int c = 0; c < SEQ / 128; ++c) {
        asm volatile("" ::: "memory");
        const int t = c * 128 + w * 16 + fr;
        v2u raw[4][4], graw[4];
#pragma unroll
        for (int k = 0; k < 4; ++k)
#pragma unroll
            for (int g = 0; g < 4; ++g) raw[k][g] = nraw[k][g];
#pragma unroll
        for (int g = 0; g < 4; ++g) graw[g] = ngraw[g];
        if (c + 1 < SEQ / 128) MB_LOAD(c + 1);
        float xr[16];
#pragma unroll
        for (int g = 0; g < 4; ++g) { f32x4 acc = *(const LAS f32x4*)(cst + 4 * 64 + 16 * g + 4 * fq);
#pragma unroll
            for (int k = 0; k < 4; ++k) { const f32x4 wk = *(const LAS f32x4*)(cst + k * 64 + 16 * g + 4 * fq);
                acc.x += wk.x * bflo(raw[k][g].x); acc.y += wk.y * bfhi(raw[k][g].x); acc.z += wk.z * bflo(raw[k][g].y); acc.w += wk.w * bfhi(raw[k][g].y); }
            xr[4 * g] = acc.x; xr[4 * g + 1] = acc.y; xr[4 * g + 2] = acc.z; xr[4 * g + 3] = acc.w; }
        bf16x8 xb[2];
#pragma unroll
        for (int s = 0; s < 2; ++s) { const unsigned p0 = pk2(xr[8 * s], xr[8 * s + 1]), p1 = pk2(xr[8 * s + 2], xr[8 * s + 3]), p2 = pk2(xr[8 * s + 4], xr[8 * s + 5]), p3 = pk2(xr[8 * s + 6], xr[8 * s + 7]);
            xb[s] = __builtin_bit_cast(bf16x8, (v4u){p0, p1, p2, p3}); }
        float av[16], bv[16];
#pragma unroll
        for (int mt = 0; mt < 4; ++mt) { f32x4 ga = {0.f, 0.f, 0.f, 0.f}, gx = {0.f, 0.f, 0.f, 0.f};
            asm volatile("" : "+v"(ga), "+v"(gx));
#pragma unroll
            for (int s = 0; s < 2; ++s) { const bf16x8 wa_ = *(const LAS bf16x8*)(wf + (mt * 2 + s) * 1024 + lane * 16), wx_ = *(const LAS bf16x8*)(wf + (8 + mt * 2 + s) * 1024 + lane * 16);
                ga = __builtin_amdgcn_mfma_f32_16x16x32_bf16(wa_, xb[s], ga, 0, 0, 0); gx = __builtin_amdgcn_mfma_f32_16x16x32_bf16(wx_, xb[s], gx, 0, 0, 0); }
            const f32x4 ba4 = *(const LAS f32x4*)(cst + 5 * 64 + 16 * mt + 4 * fq), bx4 = *(const LAS f32x4*)(cst + 6 * 64 + 16 * mt + 4 * fq), cl4 = *(const LAS f32x4*)(cst + 7 * 64 + 16 * mt + 4 * fq);
#pragma unroll
            for (int r = 0; r < 4; ++r) { const float ra = fsigmoid(ga[r] + ba4[r]), ia = fsigmoid(gx[r] + bx4[r]); const float la = cl4[r] * ra;
                const float a = __expf(la); const float m2 = fmaxf(1.f - __expf(2.f * la), 0.f);
                av[4 * mt + r] = a; bv[4 * mt + r] = __builtin_sqrtf(m2) * ia * xr[4 * mt + r]; } }
        scan_step<1>(av, bv); scan_step<2>(av, bv); scan_step<4>(av, bv); scan_step<8>(av, bv);
        LAS float* ag = agg + (c & 1) * 1024;
        if (fr == 15) {
#pragma unroll
            for (int g = 0; g < 4; ++g) { LAS float* p = ag + (w * 64 + 16 * g + 4 * fq) * 2;
                *(LAS f32x4*)p = (f32x4){av[4 * g], bv[4 * g], av[4 * g + 1], bv[4 * g + 1]}; *(LAS f32x4*)(p + 4) = (f32x4){av[4 * g + 2], bv[4 * g + 2], av[4 * g + 3], bv[4 * g + 3]}; }
        }
        LDS_BARRIER();
        float hin[16];
#pragma unroll
        for (int i = 0; i < 16; ++i) hin[i] = 0.f;
#pragma unroll
        for (int w2 = 0; w2 < 8; ++w2) {
            if (w2 == w) {
#pragma unroll
                for (int i = 0; i < 16; ++i) hin[i] = hc[i]; }
#pragma unroll
            for (int g = 0; g < 4; ++g) { const LAS float* p = ag + (w2 * 64 + 16 * g + 4 * fq) * 2; const f32x4 q0 = *(const LAS f32x4*)p, q1 = *(const LAS f32x4*)(p + 4);
                hc[4 * g] = q0.x * hc[4 * g] + q0.y; hc[4 * g + 1] = q0.z * hc[4 * g + 1] + q0.w; hc[4 * g + 2] = q1.x * hc[4 * g + 2] + q1.y; hc[4 * g + 3] = q1.z * hc[4 * g + 3] + q1.w; }
        }
#pragma unroll
        for (int g = 0; g < 4; ++g) { float y[4];
#pragma unroll
            for (int r = 0; r < 4; ++r) { const int i = 4 * g + r; const float hv = bv[i] + av[i] * hin[i];
                const float gt = (r & 1) ? bfhi(r < 2 ? graw[g].x : graw[g].y) : bflo(r < 2 ? graw[g].x : graw[g].y);
                const float inner = 1.5957691216057308f * (gt + 0.044715f * gt * gt * gt);
                y[r] = hv * gt * fsigmoid(inner); }
            *(v2u*)(py + (size_t)t * DM + 16 * g) = (v2u){pk2(y[0], y[1]), pk2(y[2], y[3])}; }
    }
}

__device__ __forceinline__ int crow(int i, int hh) { return (i & 3) + 8 * (i >> 2) + 4 * hh; }
constexpr int AK_PITCH = 272, AV_PITCH = 80, AK_BYTES = 32 * AK_PITCH, AV_BYTES = 128 * AV_PITCH, A_FLAGS = 4 * AK_BYTES + 4 * AV_BYTES;
constexpr float SB_DONE = -160.f;
__device__ __forceinline__ void attn_unit(const bf16* Q, const bf16* K, const bf16* Vt, bf16* Y, int unit, LAS unsigned char* lds, int tid) {
    const int qb = unit & 31, hp = (unit >> 5) & 7, b = unit >> 8;
    const int lane = tid & 63, w = __builtin_amdgcn_readfirstlane(tid >> 6), qi = lane & 31, hh = lane >> 5;
    const int hsel = w >> 2, wl = w & 3, h = 2 * hp + hsel;
    const int q0 = qb * 128, tq = q0 + 32 * wl + qi;
    LAS int* flags = (LAS int*)(lds + A_FLAGS);
    __syncthreads();
    if (tid < 16) flags[tid] = 0;
    bf16x8 qf[8];
    { const bf16* qp = Q + (size_t)(b * SEQ + tq) * DM + h * 128 + 8 * hh;
#pragma unroll
      for (int ks = 0; ks < 8; ++ks) qf[ks] = *(const bf16x8*)(qp + 16 * ks); }
    f32x16 o[4];
#pragma unroll
    for (int dt = 0; dt < 4; ++dt)
#pragma unroll
        for (int i = 0; i < 16; ++i) o[dt][i] = 0.f;
#pragma unroll
    for (int dt = 0; dt < 4; ++dt) asm volatile("" : "+v"(o[dt]));
    float carry = 0.f; bool done = false;
    const int ktop = 4 * qb + 3, ktw = 4 * qb + wl;
    const int kkey = tid >> 4, kc = tid & 15;
    const int vd = tid >> 2, vc4 = tid & 3;
    const bf16* kg = K + (size_t)(b * SEQ + kkey) * DM + (2 * hp) * 128 + 8 * kc;
    const bf16* vg = Vt + ((size_t)((b * 16 + 2 * hp) * 128 + vd) << 12) + 8 * vc4;
    const int kdst = kkey * AK_PITCH + 16 * kc;
    const int vdst = vd * AV_PITCH + 2 * (16 * (vc4 >> 1) + 4 * (vc4 & 1));
    v4u kr[2], vr[2];
#define A_LOAD(kt) do { _Pragma("unroll") for (int i_ = 0; i_ < 2; ++i_) { kr[i_] = *(const v4u*)(kg + i_ * 128 + (size_t)(32 * (kt)) * DM); vr[i_] = *(const v4u*)(vg + ((size_t)(128 * i_) << 12) + 32 * (kt)); } } while (0)
#define A_WRITE(bufi) do { _Pragma("unroll") for (int i_ = 0; i_ < 2; ++i_) { *(LAS v4u*)(lds + ((bufi) * 2 + i_) * AK_BYTES + kdst) = kr[i_]; \
        LAS unsigned char* vp_ = lds + 4 * AK_BYTES + ((bufi) * 2 + i_) * AV_BYTES + vdst; *(LAS v2u*)vp_ = (v2u){vr[i_].x, vr[i_].y}; *(LAS v2u*)(vp_ + 16) = (v2u){vr[i_].z, vr[i_].w}; } } while (0)
    A_LOAD(ktop); A_WRITE(0);
    if (ktop > 0) A_LOAD(ktop - 1);
    v4u kr2[2], vr2[2];
#pragma unroll
    for (int i_ = 0; i_ < 2; ++i_) { kr2[i_] = kr[i_]; vr2[i_] = vr[i_]; }
    for (int it = 0, kt = ktop; ; ++it, --kt) {
        const int cur = it & 1;
        if (kt > 1) {
#pragma unroll
            for (int i_ = 0; i_ < 2; ++i_) { kr2[i_] = *(const v4u*)(kg + i_ * 128 + (size_t)(32 * (kt - 2)) * DM); vr2[i_] = *(const v4u*)(vg + ((size_t)(128 * i_) << 12) + 32 * (kt - 2)); } }
        LDS_BARRIER();
        if (it > 0) { const LAS int* f = flags + ((it - 1) & 1) * 8; int all = 1;
#pragma unroll
            for (int i = 0; i < 8; ++i) all &= f[i];
            if (all) break; }
        if (!done && kt <= ktw) {
            const bool diag = (kt == ktw);
            const LAS unsigned char* kb_ = lds + (cur * 2 + hsel) * AK_BYTES; const LAS unsigned char* vb_ = lds + 4 * AK_BYTES + (cur * 2 + hsel) * AV_BYTES;
            const int key0 = 32 * kt;
            f32x16 s;
#pragma unroll
            for (int i = 0; i < 16; ++i) s[i] = 0.f;
            asm volatile("" : "+v"(s));
#pragma unroll
            for (int ks = 0; ks < 8; ++ks) { const bf16x8 kf = *(const LAS bf16x8*)(kb_ + qi * AK_PITCH + 32 * ks + 16 * hh);
                s = __builtin_amdgcn_mfma_f32_32x32x16_bf16(kf, qf[ks], s, 0, 0, 0); }
            float ln[16], lw[16];
#pragma unroll
            for (int i = 0; i < 16; ++i) { const float z = s[i]; const float tt = __builtin_amdgcn_exp2f(-fabsf(z)); const float L = fmaxf(z, 0.f) + __builtin_amdgcn_logf(1.f + tt);
                const bool valid = !diag || (key0 + crow(i, hh) < tq);
                ln[i] = valid ? -L : 0.f; lw[i] = valid ? (z - L) : -1e30f; }
            float so[4], sp[4], tot[4];
#pragma unroll
            for (int g = 0; g < 4; ++g) { so[g] = (ln[4 * g] + ln[4 * g + 1]) + (ln[4 * g + 2] + ln[4 * g + 3]); sp[g] = __shfl_xor(so[g], 32); tot[g] = so[g] + sp[g]; }
            float after[4];
            after[3] = (hh == 0) ? sp[3] : 0.f;
            after[2] = tot[3] + ((hh == 0) ? sp[2] : 0.f);
            after[1] = tot[3] + tot[2] + ((hh == 0) ? sp[1] : 0.f);
            after[0] = tot[3] + tot[2] + tot[1] + ((hh == 0) ? sp[0] : 0.f);
            float wv[16];
#pragma unroll
            for (int g = 0; g < 4; ++g) { const float x3 = carry + after[g], x2 = x3 + ln[4 * g + 3], x1 = x2 + ln[4 * g + 2], x0 = x1 + ln[4 * g + 1];
                wv[4 * g + 3] = __builtin_amdgcn_exp2f(lw[4 * g + 3] + x3); wv[4 * g + 2] = __builtin_amdgcn_exp2f(lw[4 * g + 2] + x2);
                wv[4 * g + 1] = __builtin_amdgcn_exp2f(lw[4 * g + 1] + x1); wv[4 * g] = __builtin_amdgcn_exp2f(lw[4 * g] + x0); }
            carry += (tot[0] + tot[1]) + (tot[2] + tot[3]);
            const bf16x8 pa0 = __builtin_bit_cast(bf16x8, (v4u){pk2(wv[0], wv[1]), pk2(wv[2], wv[3]), pk2(wv[4], wv[5]), pk2(wv[6], wv[7])});
            const bf16x8 pa1 = __builtin_bit_cast(bf16x8, (v4u){pk2(wv[8], wv[9]), pk2(wv[10], wv[11]), pk2(wv[12], wv[13]), pk2(wv[14], wv[15])});
#pragma unroll
            for (int dt = 0; dt < 4; ++dt) { const LAS unsigned char* vp = vb_ + (32 * dt + qi) * AV_PITCH + 16 * hh;
                const bf16x8 v0 = *(const LAS bf16x8*)vp, v1 = *(const LAS bf16x8*)(vp + 32);
                o[dt] = __builtin_amdgcn_mfma_f32_32x32x16_bf16(v0, pa0, o[dt], 0, 0, 0); o[dt] = __builtin_amdgcn_mfma_f32_32x32x16_bf16(v1, pa1, o[dt], 0, 0, 0); }
            done = (__builtin_amdgcn_ballot_w64(carry > SB_DONE) == 0ull);
        }
        if (lane == 0) flags[cur * 8 + w] = done ? 1 : 0;
        if (kt == 0) break;
        A_WRITE(cur ^ 1);
#pragma unroll
        for (int i_ = 0; i_ < 2; ++i_) { kr[i_] = kr2[i_]; vr[i_] = vr2[i_]; }
    }
#undef A_LOAD
#undef A_WRITE
    bf16* yp = Y + (size_t)(b * SEQ + tq) * DM + h * 128 + 4 * hh;
#pragma unroll
    for (int dt = 0; dt < 4; ++dt)
#pragma unroll
        for (int g = 0; g < 4; ++g) *(v2u*)(yp + 32 * dt + 8 * g) = (v2u){pk2(o[dt][4 * g], o[dt][4 * g + 1]), pk2(o[dt][4 * g + 2], o[dt][4 * g + 3])};
}

#define XB_TMO      128
#define XB_XCNT(j)  (256  + 64 * (j))
#define XB_XSUB(j)  (1280 + 64 * (j))
#define XB_XGEN(j)  (2304 + 64 * (j))
#define XB_TOP      3328
#define XB_TOPGEN   3392
#define XCD_BAR_WORDS 3456
#define XB_SPIN_CAP (1u << 18)

__device__ __forceinline__ unsigned xb_ld(unsigned* p)              { return __hip_atomic_load(p, __ATOMIC_RELAXED, __HIP_MEMORY_SCOPE_AGENT); }
__device__ __forceinline__ unsigned xb_add(unsigned* p, unsigned v) { return __hip_atomic_fetch_add(p, v, __ATOMIC_RELAXED, __HIP_MEMORY_SCOPE_AGENT); }
__device__ __forceinline__ unsigned xb_xcc_id() { return (unsigned)__builtin_amdgcn_s_getreg((3 << 11) | 20) & 0xFu; }
#define XB_SPIN(cond, bar) do { unsigned _sp = 0; while (cond) { __builtin_amdgcn_s_sleep(1); \
    if ((++_sp & 255u) == 0u) { if (xb_ld(&(bar)[XB_TMO])) break; if (_sp > XB_SPIN_CAP) { atomicAdd(&(bar)[XB_TMO], 1u); break; } } } } while (0)

struct XcdBarrier {
    unsigned* bar; unsigned x;
    volatile LAS unsigned* st;
};

__device__ __forceinline__ XcdBarrier xcd_barrier_post(unsigned* bar, volatile LAS unsigned* st) {
    XcdBarrier b; b.bar = bar; b.x = xb_xcc_id(); b.st = st;
    if (threadIdx.x == 0) (void)xb_add(&bar[XB_XCNT(b.x)], 1u);
    return b;
}
__device__ __forceinline__ void xcd_barrier_complete(unsigned* bar, unsigned x, unsigned& nloc, unsigned& nx) {
    const unsigned G = gridDim.x * gridDim.y * gridDim.z;
    unsigned sum, cnt, mine, sp = 0u;
    for (;;) {
        sum = 0u; cnt = 0u; mine = 0u;
#pragma unroll
        for (unsigned j = 0; j < 16; ++j) { const unsigned c = xb_ld(&bar[XB_XCNT(j)]); sum += c; cnt += (c > 0u) ? 1u : 0u; mine = (j == x) ? c : mine; }
        if (sum == G) break;
        __builtin_amdgcn_s_sleep(1);
        if ((++sp & 255u) == 0u) { if (xb_ld(&bar[XB_TMO])) break; if (sp > XB_SPIN_CAP) { atomicAdd(&bar[XB_TMO], 1u); break; } }
    }
    nloc = mine > 0u ? mine : 1u; nx = cnt > 0u ? cnt : 1u;
}

__device__ __forceinline__ void xcd_barrier(const XcdBarrier& b) {
    asm volatile("s_waitcnt vmcnt(0)" ::: "memory");
    __syncthreads();
    if (threadIdx.x == 0) {
        unsigned* bar = b.bar;
        __builtin_amdgcn_s_waitcnt(0);
        unsigned nloc = b.st[0], nx = b.st[1];
        if (nloc == 0u) { xcd_barrier_complete(bar, b.x, nloc, nx); b.st[0] = nloc; b.st[1] = nx; }
        const unsigned old = xb_add(&bar[XB_XSUB(b.x)], 1u);
        const unsigned gen = old / nloc;
        if (old + 1u == (gen + 1u) * nloc) {
            __builtin_amdgcn_fence(__ATOMIC_RELEASE, "agent");
            asm volatile("s_waitcnt vmcnt(0)" ::: "memory");
            const unsigned og = xb_add(&bar[XB_TOP], 1u);
            const unsigned tg = og / nx;
            if (og + 1u == (tg + 1u) * nx) xb_add(&bar[XB_TOPGEN], 1u);
            else XB_SPIN(xb_ld(&bar[XB_TOPGEN]) == tg, bar);
            __builtin_amdgcn_fence(__ATOMIC_ACQUIRE, "agent");
            xb_add(&bar[XB_XGEN(b.x)], 1u);
            asm volatile("s_waitcnt vmcnt(0)" ::: "memory");
        } else {
            XB_SPIN(xb_ld(&bar[XB_XGEN(b.x)]) == gen, bar);
            __builtin_amdgcn_fence(__ATOMIC_ACQUIRE, "agent");
            asm volatile("s_waitcnt vmcnt(0)" ::: "memory");
        }
    }
    __syncthreads();
}

struct Args { const float* in[16]; float* out; unsigned char* ws; };
__global__ void __launch_bounds__(NTHR, 2) mega_fwd(Args args) {
    extern __shared__ __attribute__((aligned(16))) unsigned char lds_raw[];
    LAS unsigned char* lds = (LAS unsigned char*)lds_raw;
    cg::grid_group grid = cg::this_grid();
    if (threadIdx.x < 64) ((LAS unsigned*)(lds + LDS_MISC))[threadIdx.x] = 0u;
    __syncthreads();
    const XcdBarrier bar = xcd_barrier_post((unsigned*)(args.ws + WS_CTL), (volatile LAS unsigned*)(lds + LDS_MISC) + 8);
    const int G = gridDim.x, bx = blockIdx.x, NGW = G * NWAVES;
    unsigned char* ws = args.ws;
    const float* x = args.in[0]; const float* gains = args.in[1];
    bf16* Wt_in = (bf16*)(ws + WS_WIN); bf16* Wt_out = (bf16*)(ws + WS_WOUT); bf16* Wt_qkv = (bf16*)(ws + WS_WQKV); bf16* Wt_o = (bf16*)(ws + WS_WO);
    bf16* XR = (bf16*)(ws + WS_H); bf16* MIX = (bf16*)(ws + WS_MIX); bf16* BIG = (bf16*)(ws + WS_BIG); float* RS = (float*)(ws + WS_RS);
    float* out = args.out; bf16* Yb = (bf16*)args.out;

    bf16* Qb = BIG; bf16* Kb = BIG + (size_t)MTOK * DM; bf16* Vtb = BIG + 2 * (size_t)MTOK * DM;
    for (int ph = 0; ph < 15; ++ph) {
        int tid = threadIdx.x; asm volatile("" : "+v"(tid));
        const int lane = tid & 63, wave = __builtin_amdgcn_readfirstlane(tid >> 6), gw = bx * NWAVES + wave;
        const int layer = ph >= 8 ? 1 : 0;
        const float* g = gains + (size_t)layer * 4 * DM;
        int gk = -1;
        if (ph == 1 || ph == 3 || ph == 5 || ph == 6 || ph == 8 || ph == 10 || ph == 12 || ph == 13) gk = ph;
        if (gk >= 0) {
#ifndef NO_GEMM
            pg8::Gemm gm{XR, Wt_in, MTOK, DIN, DM}; pg8::EpiGen E{0, BIG, DIN, Kb, Vtb, 0.08838834764831845f * 1.4426950408889634f, RS};
            if (gk == 3) { gm.A = Yb; gm.Bt = Wt_out; gm.N = DM; E.O = MIX; E.ldc = DM; E.rowscale = nullptr; }
            else if (gk == 5 || gk == 12) { gm.Bt = (const bf16*)(ws + (gk == 12 ? WS_WUP1 : WS_WUP0)); gm.N = DFF; E.mode = 2; E.ldc = DFF; }
            else if (gk == 6 || gk == 13) { gm.A = BIG; gm.Bt = (const bf16*)(ws + (gk == 13 ? WS_WDN1 : WS_WDN0)); gm.N = DM; gm.K = DFF; E.O = MIX; E.ldc = DM; E.rowscale = nullptr; }
            else if (gk == 8) { gm.Bt = Wt_qkv; gm.N = NQKV; E.mode = 3; E.O = Qb; E.ldc = DM; }
            else if (gk == 10) { gm.A = Yb; gm.Bt = Wt_o; gm.N = DM; E.O = MIX; E.ldc = DM; E.rowscale = nullptr; }
            pg8::StaticOrder S; S.init(MTOK, gm.N, G, bx);
            pg8::gemm_phase<pg8::EpiGen, pg8::StaticOrder, true, true>(lds, gm, S, E);
#endif
        } else if (ph == 0) {
#ifndef NO_P0
            LAS float* scr = (LAS float*)(lds + wave * 16384);
            constexpr int I_IN = 32 * 160, I_OUT = 32 * 64, I_QKV = 32 * 192, I_O = 32 * 64, I_UP = 32 * 256, I_DN = 128 * 64;
            constexpr int NITEMS = I_IN + I_OUT + I_QKV + I_O + 2 * I_UP + 2 * I_DN;
            for (int it = gw; it < NITEMS; it += NGW) {
                int r = it;
                if (r < I_IN) { p0_transpose_item(args.in[2], DM, DIN, Wt_in, scr, r, lane, gains); continue; } r -= I_IN;
                if (r < I_OUT) { p0_transpose_item(args.in[11], DM, DM, Wt_out, scr, r, lane); continue; } r -= I_OUT;
                if (r < I_QKV) { p0_transpose_item(args.in[12], DM, NQKV, Wt_qkv, scr, r, lane, gains + 4 * DM); continue; } r -= I_QKV;
                if (r < I_O) { p0_transpose_item(args.in[13], DM, DM, Wt_o, scr, r, lane); continue; } r -= I_O;
                if (r < 2 * I_UP) { const int l = r / I_UP; p0_transpose_item(args.in[14] + (size_t)l * DM * DFF, DM, DFF, (bf16*)(ws + (l ? WS_WUP1 : WS_WUP0)), scr, r - l * I_UP, lane, gains + (size_t)(l * 4 + 2) * DM); continue; } r -= 2 * I_UP;
                { const int l = r / I_DN; p0_transpose_item(args.in[15] + (size_t)l * DFF * DM, DFF, DM, (bf16*)(ws + (l ? WS_WDN1 : WS_WDN0)), scr, r - l * I_DN, lane); }
            }
            cvt_rows(x, XR, RS, gw, NGW, lane);
#endif
        } else if (ph == 2) {
#ifndef NO_MIX
            constexpr int NB = BATCH * 16, NA = MTOK / 64;
            for (int it = bx; it < NB + NA; it += G) {
                if (it < NB) mixerB_item(BIG, args.in[4], args.in[5], args.in[6], args.in[7], args.in[8], args.in[9], args.in[10], Yb, it, lds, tid);
                else mixerA_item(BIG, args.in[3], Yb, it - NB, tid);
            }
#endif
        } else if (ph == 9) {
#ifndef NO_ATTN
            if (G == 256) { for (int k = 0; k < 8; ++k) attn_unit(Qb, Kb, Vtb, Yb, (((k << 3) | (bx & 7)) << 5) | (bx >> 3), lds, tid); }
            else { for (int u = bx; u < BATCH * 8 * 32; u += G) attn_unit(Qb, Kb, Vtb, Yb, u, lds, tid); }
#endif
        } else {
#ifndef NO_POST
            const float* gpost = (ph == 4 || ph == 11) ? g + DM : g + 3 * DM;
            if (ph == 14) post_rows<true>(MIX, XR, out, gpost, RS, gw, NGW, lane); else post_rows<false>(MIX, XR, out, gpost, RS, gw, NGW, lane);
#endif
        }
        if (ph == 0) grid.sync(); else if (ph < 14) xcd_barrier(bar);
    }
}

extern "C" void kernel_launch(void* const* d_in, const int* in_sizes, int n_in, void* d_out, int out_size, void* d_ws, size_t ws_size, hipStream_t stream) {
    static int grid = 0;
    if (grid == 0) {
        if (n_in != 16 || in_sizes[0] != MTOK * DM || out_size != MTOK * DM || ws_size < WS_END) { fprintf(stderr, "kernel_launch: unexpected shapes / workspace (n_in %d, ws %zu); nothing launched\n", n_in, ws_size); grid = -1; return; }
        int dev = 0, cus = 0, per_cu = 0;
        if (hipGetDevice(&dev) != hipSuccess || hipDeviceGetAttribute(&cus, hipDeviceAttributeMultiprocessorCount, dev) != hipSuccess) { grid = -1; return; }
        if (hipFuncSetAttribute((const void*)mega_fwd, hipFuncAttributeMaxDynamicSharedMemorySize, LDS_BYTES) != hipSuccess) { fprintf(stderr, "kernel_launch: hipFuncSetAttribute failed\n"); grid = -1; return; }
        if (hipOccupancyMaxActiveBlocksPerMultiprocessor(&per_cu, (const void*)mega_fwd, NTHR, LDS_BYTES) != hipSuccess || per_cu < 1) { fprintf(stderr, "kernel_launch: occupancy query says %d\n", per_cu); per_cu = 1; }
        (void)hipGetLastError();
        grid = cus;
    }
    if (grid < 0) return;
    if (hipMemsetAsync((char*)d_ws + WS_CTL, 0, CTL_BYTES, stream) != hipSuccess) { fprintf(stderr, "kernel_launch: memset of the barrier words failed\n"); return; }
    Args a{};
    for (int i = 0; i < 16; ++i) a.in[i] = (const float*)d_in[i];
    a.out = (float*)d_out; a.ws = (unsigned char*)d_ws;
    void* kargs[] = {&a};
    hipError_t e = hipLaunchCooperativeKernel((const void*)mega_fwd, dim3(grid), dim3(NTHR), kargs, LDS_BYTES, stream);
    if (e != hipSuccess) fprintf(stderr, "kernel_launch: cooperative launch failed: %s (grid %d)\n", hipGetErrorString(e), grid);
}
```

```cpp
#include <hip/hip_runtime.h>
#include <hip/hip_cooperative_groups.h>
#include <cstdio>
#include <cstdint>
namespace cg = cooperative_groups;
namespace pg8 {
#define PG8_LAS __attribute__((address_space(3)))
typedef unsigned short bf16_t;
typedef short bf16x8 __attribute__((ext_vector_type(8)));
typedef float f32x4 __attribute__((ext_vector_type(4)));
typedef unsigned u32x4 __attribute__((ext_vector_type(4)));
constexpr int BM = 256, BK = 64, HALF = 128, HTB = HALF * BK * 2  , STAGE_BYTES = 8 * HTB, NXCD = 8, WGM = 8;

__host__ __device__ __forceinline__ int lds_byte(int r, int c) { const int st = (r >> 4) * 2 + (c >> 5), rr = r & 15, cc = c & 31, ob = rr * 64 + cc * 2; return st * 1024 + (ob ^ (((ob >> 9) & 1) << 5)); }
__host__ __device__ __forceinline__ void stage_rc(int b, int& R, int& C) { const int st = b / 1024, sb = b % 1024, swz = sb ^ (((sb >> 9) & 1) << 5); R = (st >> 1) * 16 + swz / 64; C = (st & 1) * 32 + (swz % 64) / 2; }
__host__ __device__ __forceinline__ int perm32(int rho) { const int n = rho >> 4, i = rho & 15; return 8 * (i >> 2) + 4 * n + (i & 3); }

struct Unit { int pm, pn; };
struct Gemm { const bf16_t* A; const bf16_t* Bt; int M, N, K; };

struct StaticOrder {
    int nM, nN, nwg, G, c;
    __host__ __device__ void init(int M, int N, int G_, int c_) { nM = M / BM; nN = N / BM; nwg = nM * nN; G = G_; c = c_; }
    __host__ __device__ bool next(int i, Unit& u) const {
        const long L = (long)i * G + c; if (L >= nwg) return false;
        int wgid = (int)L; { const int q = nwg / NXCD, r = nwg % NXCD, xcd = wgid % NXCD, off = wgid / NXCD; wgid = (xcd < r ? xcd * (q + 1) : r * (q + 1) + (xcd - r) * q) + off; }
        const int nig = WGM * nN, gid = wgid / nig, fm = gid * WGM, gsz = (nM - fm) < WGM ? (nM - fm) : WGM;
        u.pm = fm + ((wgid % nig) % gsz); u.pn = (wgid % nig) / gsz; return true;
    }
    __device__ __forceinline__ void a_ready(const Unit&) const {}
    __device__ __forceinline__ void done(const Unit&) const {}
};
__device__ __forceinline__ unsigned cvt_pk_bf16(float lo, float hi) { unsigned r; asm volatile("v_cvt_pk_bf16_f32 %0, %1, %2" : "=v"(r) : "v"(lo), "v"(hi)); return r; }
typedef float f32x2 __attribute__((ext_vector_type(2)));
__device__ __forceinline__ unsigned short f2bf1(float f) { unsigned u = __builtin_bit_cast(unsigned, f); return (unsigned short)((u + 0x7fffu + ((u >> 16) & 1u)) >> 16); }

struct EpiGen {
    static constexpr bool PERM = true, AFTER_DRAIN = false;
    int mode; bf16_t* O; int ldc; bf16_t* K; bf16_t* Vt; float qscale; const float* rowscale;
    __device__ __forceinline__ void operator()(const f32x4 (&acc)[2][2][4][2], const Unit& u, int wr, int wc, int fr, int fq) const {
        const int t3 = u.pn >> 3;
        if (mode == 3 && t3 == 2) {
            const int cv0 = (u.pn - 16) * BM + wc * 32 + 8 * fq;
#pragma unroll
            for (int ai = 0; ai < 2; ++ai)
#pragma unroll
                for (int m = 0; m < 4; ++m) { const int r = u.pm * BM + ai * HALF + wr * 64 + m * 16 + fr; const int b = r >> 12, t = r & 4095; const float rsv = rowscale ? rowscale[r] : 1.f;
#pragma unroll
                    for (int bj = 0; bj < 2; ++bj)
#pragma unroll
                        for (int n = 0; n < 2; ++n)
#pragma unroll
                            for (int e = 0; e < 4; ++e) { const int cv = cv0 + bj * HALF + 4 * n + e; const int head = cv >> 7, d = cv & 127;
                                Vt[((size_t)((b * 16 + head) * 128 + d) << 12) + t] = f2bf1(acc[ai][bj][m][n][e] * rsv); } }
            return;
        }
        bf16_t* base = O; float sc = 1.f; int colt = u.pn * BM;
        if (mode == 3) { colt = (u.pn & 7) * BM; if (t3) base = K; else sc = qscale; }
        const bool sq = (mode == 2);
        const int row0 = u.pm * BM + wr * 64 + fr; const int col0 = colt + wc * 32 + 8 * fq;
#pragma unroll
        for (int ai = 0; ai < 2; ++ai)
#pragma unroll
            for (int m = 0; m < 4; ++m) { bf16_t* rowp = base + (size_t)(row0 + ai * HALF + m * 16) * ldc + col0; const float rsc = (rowscale ? rowscale[row0 + ai * HALF + m * 16] : 1.f) * sc;
#pragma unroll
                for (int bj = 0; bj < 2; ++bj) { f32x4 v0 = acc[ai][bj][m][0] * rsc, v1 = acc[ai][bj][m][1] * rsc;
                    if (sq) {
#pragma unroll
                        for (int e = 0; e < 4; ++e) { float a = v0[e] > 0.f ? v0[e] : 0.f; v0[e] = a * a; float b = v1[e] > 0.f ? v1[e] : 0.f; v1[e] = b * b; } }
                    u32x4 w; w.x = cvt_pk_bf16(v0[0], v0[1]); w.y = cvt_pk_bf16(v0[2], v0[3]); w.z = cvt_pk_bf16(v1[0], v1[1]); w.w = cvt_pk_bf16(v1[2], v1[3]);
                    *(u32x4*)(rowp + bj * HALF) = w; } }
    }
};

template <class Epi, class Sched, bool ALIGN_EPI = false, bool SP2 = false>
__device__ __forceinline__ void gemm_phase(PG8_LAS unsigned char* lds, const Gemm g, const Sched& S, const Epi& E) {
    int tid = threadIdx.x; asm volatile("" : "+v"(tid)); const int wid = __builtin_amdgcn_readfirstlane(tid >> 6), lane = tid & 63, wr = wid >> 2, wc = wid & 3, fr = lane & 15, fq = lane >> 4;
    const int K = g.K, nt = K / BK;
    unsigned voffA[2], voffB[2];
#pragma unroll
    for (int i = 0; i < 2; ++i) { int R, C; stage_rc(tid * 16 + i * 8192, R, C); const int Rb = Epi::PERM ? ((R & ~31) + perm32(R & 31)) : R;
        voffA[i] = (unsigned)(R * K + C) * 2u; voffB[i] = (unsigned)(Rb * K + C) * 2u; }
    const size_t kstep = (size_t)(BK * 2);
    const size_t hstep = (size_t)HALF * K * 2;
    const size_t tstep = 2 * hstep;
    const unsigned ldsw = (unsigned)wid * 1024u;
    const int aoff = lds_byte(wr * 64 + fr, fq * 8), boff = lds_byte(wc * 32 + fr, fq * 8);
#define PG8_SA(b, h) (((b) * 2 + (h)) * HTB)
#define PG8_SB(b, h) ((4 + (b) * 2 + (h)) * HTB)
#define PG8_STAGE(bufoff, gbase, voff) do { _Pragma("unroll") for (int _i = 0; _i < 2; ++_i) \
        __builtin_amdgcn_global_load_lds((const unsigned*)((const char*)(gbase) + (voff)[_i]), (PG8_LAS unsigned*)(lds + (bufoff) + ldsw + _i * 8192), 16, 0, 0); } while (0)
#define PG8_LDA(dst, b, h) do { _Pragma("unroll") for (int m = 0; m < 4; ++m) _Pragma("unroll") for (int k = 0; k < 2; ++k) dst[m][k] = *(const PG8_LAS bf16x8*)(lds + PG8_SA(b, h) + aoff + m * 2048 + k * 1024); } while (0)
#define PG8_LDB(dst, b, h) do { _Pragma("unroll") for (int n = 0; n < 2; ++n) _Pragma("unroll") for (int k = 0; k < 2; ++k) dst[n][k] = *(const PG8_LAS bf16x8*)(lds + PG8_SB(b, h) + boff + n * 2048 + k * 1024); } while (0)
#define PG8_MMA(ai, bj, At, Bt) do { __builtin_amdgcn_s_setprio(1); _Pragma("unroll") for (int m = 0; m < 4; ++m) _Pragma("unroll") for (int n = 0; n < 2; ++n) _Pragma("unroll") for (int k = 0; k < 2; ++k) \
        acc[ai][bj][m][n] = __builtin_amdgcn_mfma_f32_16x16x32_bf16(Bt[n][k], At[m][k], acc[ai][bj][m][n], 0, 0, 0); __builtin_amdgcn_s_setprio(0); } while (0)
#define PG8_WAIT_V(n) asm volatile("s_waitcnt vmcnt(" #n ")" ::: "memory")
#define PG8_WAIT_L(n) asm volatile("s_waitcnt lgkmcnt(" #n ")" ::: "memory")
#define PG8_BAR __builtin_amdgcn_s_barrier()
#define PG8_SCHED __builtin_amdgcn_sched_barrier(0)
    Unit cur, nxt; int ui = 0;
    if (!S.next(0, cur)) return;
    f32x4 acc[2][2][4][2];
#pragma unroll
    for (int a = 0; a < 2; ++a)
#pragma unroll
        for (int b = 0; b < 2; ++b)
#pragma unroll
            for (int m = 0; m < 4; ++m)
#pragma unroll
                for (int n = 0; n < 2; ++n) acc[a][b][m][n] = (f32x4){0.f, 0.f, 0.f, 0.f};
    bf16x8 At[4][2], B0[2][2], B1[2][2];
    const char* cA = (const char*)g.A + (size_t)cur.pm * tstep; const char* cB = (const char*)g.Bt + (size_t)cur.pn * tstep;
    S.a_ready(cur);
    if constexpr (SP2) {
        PG8_STAGE(PG8_SB(0, 0), cB, voffB); PG8_STAGE(PG8_SB(0, 1), cB + hstep, voffB); PG8_STAGE(PG8_SA(0, 0), cA, voffA); PG8_STAGE(PG8_SA(0, 1), cA + hstep, voffA);
        if (wr == 1) PG8_BAR;
        PG8_WAIT_V(2); PG8_BAR;
        PG8_STAGE(PG8_SB(1, 0), cB + kstep, voffB); PG8_STAGE(PG8_SA(1, 0), cA + kstep, voffA); PG8_STAGE(PG8_SB(1, 1), cB + hstep + kstep, voffB);
        PG8_WAIT_V(6); PG8_BAR;
    } else {
        PG8_STAGE(PG8_SB(0, 0), cB, voffB); PG8_STAGE(PG8_SA(0, 0), cA, voffA); PG8_STAGE(PG8_SB(0, 1), cB + hstep, voffB); PG8_STAGE(PG8_SA(0, 1), cA + hstep, voffA);
        if (wr == 1) PG8_BAR;
        PG8_WAIT_V(4); PG8_BAR;
        PG8_STAGE(PG8_SB(1, 0), cB + kstep, voffB); PG8_STAGE(PG8_SA(1, 0), cA + kstep, voffA); PG8_STAGE(PG8_SB(1, 1), cB + hstep + kstep, voffB);
        PG8_WAIT_V(6); PG8_BAR;
    }
    for (;;) {
        const bool has_next = S.next(ui + 1, nxt);
        const char* nA = has_next ? (const char*)g.A + (size_t)nxt.pm * tstep : cA; const char* nB = has_next ? (const char*)g.Bt + (size_t)nxt.pn * tstep : cB;
        for (int t = 0; t < nt; t += 2) {
            const bool last = (t == nt - 2);
            const char* a1 = cA + (size_t)(t + 1) * kstep;
            const char* a2 = last ? nA : cA + (size_t)(t + 2) * kstep; const char* b2 = last ? nB : cB + (size_t)(t + 2) * kstep;
            const char* a3 = a2 + kstep; const char* b3 = b2 + kstep;
            if (last && has_next) S.a_ready(nxt);
            if constexpr (SP2) {
            PG8_LDB(B0, 0, 0); PG8_LDB(B1, 0, 1); PG8_SCHED; PG8_LDA(At, 0, 0); PG8_STAGE(PG8_SA(1, 1), a1 + hstep, voffA);
            PG8_WAIT_V(8); PG8_WAIT_L(0); PG8_BAR; PG8_MMA(0, 0, At, B0); PG8_MMA(0, 1, At, B1); PG8_BAR; PG8_SCHED;
            PG8_LDA(At, 0, 1); PG8_STAGE(PG8_SB(0, 0), b2, voffB); PG8_STAGE(PG8_SB(0, 1), b2 + hstep, voffB); PG8_STAGE(PG8_SA(0, 0), a2, voffA);
            PG8_WAIT_V(8); PG8_WAIT_L(0); PG8_BAR; PG8_MMA(1, 0, At, B0); PG8_MMA(1, 1, At, B1); PG8_BAR; PG8_SCHED;
            PG8_LDB(B0, 1, 0); PG8_LDB(B1, 1, 1); PG8_SCHED; PG8_LDA(At, 1, 0); PG8_STAGE(PG8_SA(0, 1), a2 + hstep, voffA);
            PG8_WAIT_V(8); PG8_WAIT_L(0); PG8_BAR; PG8_MMA(0, 0, At, B0); PG8_MMA(0, 1, At, B1); PG8_BAR; PG8_SCHED;
            PG8_LDA(At, 1, 1); PG8_STAGE(PG8_SB(1, 0), b3, voffB); PG8_STAGE(PG8_SB(1, 1), b3 + hstep, voffB); PG8_STAGE(PG8_SA(1, 0), a3, voffA);
            PG8_WAIT_V(8); PG8_WAIT_L(0); PG8_BAR; PG8_MMA(1, 0, At, B0); PG8_MMA(1, 1, At, B1); PG8_BAR; PG8_SCHED;
            } else {
            PG8_LDB(B0, 0, 0); PG8_SCHED; PG8_LDA(At, 0, 0); PG8_STAGE(PG8_SA(1, 1), a1 + hstep, voffA);
            PG8_WAIT_L(8); PG8_BAR; PG8_WAIT_L(0); PG8_MMA(0, 0, At, B0); PG8_BAR; PG8_SCHED;
            PG8_LDB(B1, 0, 1); PG8_STAGE(PG8_SB(0, 0), b2, voffB);
            PG8_BAR; PG8_WAIT_L(0); PG8_MMA(0, 1, At, B1); PG8_BAR;
            PG8_LDA(At, 0, 1); PG8_STAGE(PG8_SA(0, 0), a2, voffA);
            PG8_BAR; PG8_WAIT_L(0); PG8_MMA(1, 0, At, B0); PG8_BAR; PG8_SCHED;
            PG8_STAGE(PG8_SB(0, 1), b2 + hstep, voffB);
            PG8_WAIT_V(6); PG8_BAR; PG8_MMA(1, 1, At, B1); PG8_BAR;
            PG8_LDB(B0, 1, 0); PG8_SCHED; PG8_LDA(At, 1, 0); PG8_STAGE(PG8_SA(0, 1), a2 + hstep, voffA);
            PG8_WAIT_L(8); PG8_BAR; PG8_WAIT_L(0); PG8_MMA(0, 0, At, B0); PG8_BAR; PG8_SCHED;
            PG8_LDB(B1, 1, 1); PG8_STAGE(PG8_SB(1, 0), b3, voffB);
            PG8_BAR; PG8_WAIT_L(0); PG8_MMA(0, 1, At, B1); PG8_BAR;
            PG8_LDA(At, 1, 1); PG8_STAGE(PG8_SA(1, 0), a3, voffA);
            PG8_BAR; PG8_WAIT_L(0); PG8_MMA(1, 0, At, B0); PG8_BAR; PG8_SCHED;
            PG8_STAGE(PG8_SB(1, 1), b3 + hstep, voffB);
            PG8_WAIT_V(6); PG8_BAR; PG8_MMA(1, 1, At, B1); PG8_BAR;
            }
        }
        if constexpr (ALIGN_EPI) { if (wr == 0) PG8_BAR; }
        if constexpr (!Epi::AFTER_DRAIN) { E(acc, cur, wr, wc, fr, fq); S.done(cur); }
        if (!has_next) break;
#pragma unroll
        for (int a = 0; a < 2; ++a)
#pragma unroll
            for (int b = 0; b < 2; ++b)
#pragma unroll
                for (int m = 0; m < 4; ++m)
#pragma unroll
                    for (int n = 0; n < 2; ++n) acc[a][b][m][n] = (f32x4){0.f, 0.f, 0.f, 0.f};
        cur = nxt; cA = nA; cB = nB; ++ui;
        if constexpr (ALIGN_EPI) { if (wr == 1) PG8_BAR; }
    }
    PG8_WAIT_V(0);
    if constexpr (!ALIGN_EPI) { if (wr == 0) PG8_BAR; }
    PG8_BAR;
    if constexpr (Epi::AFTER_DRAIN) { E.fused(acc, cur, wr, wc, fr, fq, lds, wid, lane); S.done(cur); }
#undef PG8_SA
#undef PG8_SB
#undef PG8_STAGE
#undef PG8_LDA
#undef PG8_LDB
#undef PG8_MMA
#undef PG8_WAIT_V
#undef PG8_WAIT_L
#undef PG8_BAR
#undef PG8_SCHED
}
}
#define LAS __attribute__((address_space(3)))
typedef unsigned short bf16;
typedef unsigned v4u __attribute__((ext_vector_type(4)));
typedef unsigned v2u __attribute__((ext_vector_type(2)));
typedef float f32x4 __attribute__((ext_vector_type(4)));
typedef float f32x16 __attribute__((ext_vector_type(16)));
typedef short bf16x8 __attribute__((ext_vector_type(8)));
constexpr int NWAVES = 8, NTHR = 512;
constexpr int BATCH = 8, SEQ = 4096, DM = 2048, MTOK = BATCH * SEQ, DIN = 5120, DFF = 8192, NQKV = 6144;
constexpr float NORM_EPS = 1e-6f;
constexpr size_t MiB = 1u << 20;
constexpr size_t WS_WIN = 0, WS_WOUT = 20 * MiB, WS_WQKV = 28 * MiB, WS_WO = 52 * MiB, WS_WUP0 = 60 * MiB, WS_WUP1 = 92 * MiB, WS_WDN0 = 124 * MiB, WS_WDN1 = 156 * MiB;
constexpr size_t WS_H = 192 * MiB, WS_MIX = 320 * MiB, WS_BIG = 448 * MiB, WS_CTL = 960 * MiB, CTL_BYTES = 16384, WS_RS = 960 * MiB + 65536, WS_END = 961 * MiB;
constexpr int LDS_MISC = 131072, LDS_BYTES = 131072 + 256;

__device__ __forceinline__ float bflo(unsigned u) { return __uint_as_float(u << 16); }
__device__ __forceinline__ float bfhi(unsigned u) { return __uint_as_float(u & 0xffff0000u); }
__device__ __forceinline__ unsigned pk2(float lo, float hi) { return pg8::cvt_pk_bf16(lo, hi); }
__device__ __forceinline__ float wave_sum(float v) {
#pragma unroll
    for (int o = 1; o < 64; o <<= 1) v += __shfl_xor(v, o);
    return v;
}
#define LDS_BARRIER() do { asm volatile("s_waitcnt lgkmcnt(0)" ::: "memory"); __builtin_amdgcn_s_barrier(); asm volatile("" ::: "memory"); } while (0)
__device__ __forceinline__ float fsigmoid(float x) { return __builtin_amdgcn_rcpf(1.f + __expf(-x)); }

__device__ __forceinline__ void p0_transpose_item(const float* W, int K, int N, bf16* WT, LAS float* scr, int item, int lane, const float* gk = nullptr) {
    const int nblk = N / 32, kb = item / nblk, nb = item % nblk, k0 = 64 * kb, n0 = 32 * nb;
    float tv[32];
#pragma unroll
    for (int i = 0; i < 32; ++i) tv[i] = W[(size_t)(k0 + 2 * i + (lane >> 5)) * N + n0 + (lane & 31)];
#pragma unroll
    for (int i = 0; i < 32; ++i) scr[(2 * i + (lane >> 5)) * 33 + (lane & 31)] = tv[i];
    asm volatile("s_waitcnt lgkmcnt(0)" ::: "memory");
    const int c = lane & 7;
    f32x4 g0 = {1.f, 1.f, 1.f, 1.f}, g1 = {1.f, 1.f, 1.f, 1.f};
    if (gk) { g0 = *(const f32x4*)(gk + k0 + 8 * c); g1 = *(const f32x4*)(gk + k0 + 8 * c + 4); }
#pragma unroll
    for (int j = 0; j < 4; ++j) { const int n = (lane >> 3) + 8 * j; const LAS float* s = scr + (8 * c) * 33 + n;
        v4u o; o.x = pk2(s[0 * 33] * g0.x, s[1 * 33] * g0.y); o.y = pk2(s[2 * 33] * g0.z, s[3 * 33] * g0.w); o.z = pk2(s[4 * 33] * g1.x, s[5 * 33] * g1.y); o.w = pk2(s[6 * 33] * g1.z, s[7 * 33] * g1.w);
        *(v4u*)(WT + (size_t)(n0 + n) * K + k0 + 8 * c) = o; }
    asm volatile("s_waitcnt lgkmcnt(0)" ::: "memory");
}

__device__ __forceinline__ void cvt_row(const float* xrow, bf16* orow, float* rs, int lane) {
    f32x4 v[4][2]; float ss = 0.f;
#pragma unroll
    for (int j = 0; j < 4; ++j)
#pragma unroll
        for (int e = 0; e < 2; ++e) { v[j][e] = *(const f32x4*)(xrow + 512 * j + 8 * lane + 4 * e); ss += (v[j][e].x * v[j][e].x + v[j][e].y * v[j][e].y) + (v[j][e].z * v[j][e].z + v[j][e].w * v[j][e].w); }
    const float r = __builtin_amdgcn_rsqf(wave_sum(ss) * (1.f / DM) + NORM_EPS);
#pragma unroll
    for (int j = 0; j < 4; ++j) { const f32x4 a = v[j][0], b = v[j][1];
        v4u o; o.x = pk2(a.x, a.y); o.y = pk2(a.z, a.w); o.z = pk2(b.x, b.y); o.w = pk2(b.z, b.w);
        *(v4u*)(orow + 512 * j + 8 * lane) = o; }
    if (lane == 0) *rs = r;
}

template <bool XIN_F32, bool OUT_F32>
__device__ __forceinline__ void post_row(const bf16* mrow, const float* xin_f, const bf16* xin_b, float* xout_f, bf16* xout_b, const float* gpost, float* rs, int lane) {
    f32x4 mv[4][2], xv[4][2], gp[4][2]; float ss = 0.f;
    v4u r[4], xr[4];
#pragma unroll
    for (int j = 0; j < 4; ++j) r[j] = *(const v4u*)(mrow + 512 * j + 8 * lane);
    if (XIN_F32) {
#pragma unroll
        for (int j = 0; j < 4; ++j)
#pragma unroll
            for (int e = 0; e < 2; ++e) xv[j][e] = *(const f32x4*)(xin_f + 512 * j + 8 * lane + 4 * e);
    } else {
#pragma unroll
        for (int j = 0; j < 4; ++j) xr[j] = *(const v4u*)(xin_b + 512 * j + 8 * lane);
#pragma unroll
        for (int j = 0; j < 4; ++j) { xv[j][0] = (f32x4){bflo(xr[j].x), bfhi(xr[j].x), bflo(xr[j].y), bfhi(xr[j].y)}; xv[j][1] = (f32x4){bflo(xr[j].z), bfhi(xr[j].z), bflo(xr[j].w), bfhi(xr[j].w)}; }
    }
#pragma unroll
    for (int j = 0; j < 4; ++j)
#pragma unroll
        for (int e = 0; e < 2; ++e) gp[j][e] = *(const f32x4*)(gpost + 512 * j + 8 * lane + 4 * e);
#pragma unroll
    for (int j = 0; j < 4; ++j) {
        mv[j][0] = (f32x4){bflo(r[j].x), bfhi(r[j].x), bflo(r[j].y), bfhi(r[j].y)}; mv[j][1] = (f32x4){bflo(r[j].z), bfhi(r[j].z), bflo(r[j].w), bfhi(r[j].w)};
#pragma unroll
        for (int e = 0; e < 2; ++e) ss += (mv[j][e].x * mv[j][e].x + mv[j][e].y * mv[j][e].y) + (mv[j][e].z * mv[j][e].z + mv[j][e].w * mv[j][e].w); }
    const float rs1 = __builtin_amdgcn_rsqf(wave_sum(ss) * (1.f / DM) + NORM_EPS);
    float s2 = 0.f;
#pragma unroll
    for (int j = 0; j < 4; ++j)
#pragma unroll
        for (int e = 0; e < 2; ++e) { const f32x4 x1 = xv[j][e] + mv[j][e] * rs1 * gp[j][e]; mv[j][e] = x1; s2 += (x1.x * x1.x + x1.y * x1.y) + (x1.z * x1.z + x1.w * x1.w); }
    if (OUT_F32) {
#pragma unroll
        for (int j = 0; j < 4; ++j)
#pragma unroll
            for (int e = 0; e < 2; ++e) *(f32x4*)(xout_f + 512 * j + 8 * lane + 4 * e) = mv[j][e];
    } else {
#pragma unroll
        for (int j = 0; j < 4; ++j) { const f32x4 a = mv[j][0], b = mv[j][1];
            v4u o; o.x = pk2(a.x, a.y); o.y = pk2(a.z, a.w); o.z = pk2(b.x, b.y); o.w = pk2(b.z, b.w);
            *(v4u*)(xout_b + 512 * j + 8 * lane) = o; }
        const float rs2 = __builtin_amdgcn_rsqf(wave_sum(s2) * (1.f / DM) + NORM_EPS);
        if (lane == 0) *rs = rs2;
    }
}

template <bool OUT_F32>
__device__ __forceinline__ void post_rows(const bf16* MIXb, bf16* XRb, float* outf, const float* gpost, float* RSb, int gw, int NGW, int lane) {
    f32x4 gp[4][2];
#pragma unroll
    for (int j = 0; j < 4; ++j)
#pragma unroll
        for (int e = 0; e < 2; ++e) gp[j][e] = *(const f32x4*)(gpost + 512 * j + 8 * lane + 4 * e);
    v4u nr[4], nx[4];
#pragma unroll
    for (int j = 0; j < 4; ++j) { nr[j] = *(const v4u*)(MIXb + (size_t)gw * DM + 512 * j + 8 * lane); nx[j] = *(const v4u*)(XRb + (size_t)gw * DM + 512 * j + 8 * lane); }
    for (int m = gw; m < MTOK; m += NGW) {
        v4u r[4], xr[4];
#pragma unroll
        for (int j = 0; j < 4; ++j) { r[j] = nr[j]; xr[j] = nx[j]; }
        const int mn = m + NGW;
        if (mn < MTOK) {
#pragma unroll
            for (int j = 0; j < 4; ++j) { nr[j] = *(const v4u*)(MIXb + (size_t)mn * DM + 512 * j + 8 * lane); nx[j] = *(const v4u*)(XRb + (size_t)mn * DM + 512 * j + 8 * lane); } }
        f32x4 mv[4][2]; float ss = 0.f;
#pragma unroll
        for (int j = 0; j < 4; ++j) {
            mv[j][0] = (f32x4){bflo(r[j].x), bfhi(r[j].x), bflo(r[j].y), bfhi(r[j].y)}; mv[j][1] = (f32x4){bflo(r[j].z), bfhi(r[j].z), bflo(r[j].w), bfhi(r[j].w)};
#pragma unroll
            for (int e = 0; e < 2; ++e) ss += (mv[j][e].x * mv[j][e].x + mv[j][e].y * mv[j][e].y) + (mv[j][e].z * mv[j][e].z + mv[j][e].w * mv[j][e].w); }
        const float rs1 = __builtin_amdgcn_rsqf(wave_sum(ss) * (1.f / DM) + NORM_EPS);
        float s2 = 0.f;
#pragma unroll
        for (int j = 0; j < 4; ++j) {
            const f32x4 x0 = (f32x4){bflo(xr[j].x), bfhi(xr[j].x), bflo(xr[j].y), bfhi(xr[j].y)}, x1 = (f32x4){bflo(xr[j].z), bfhi(xr[j].z), bflo(xr[j].w), bfhi(xr[j].w)};
            const f32x4 a = x0 + mv[j][0] * rs1 * gp[j][0], b = x1 + mv[j][1] * rs1 * gp[j][1]; mv[j][0] = a; mv[j][1] = b;
            s2 += ((a.x * a.x + a.y * a.y) + (a.z * a.z + a.w * a.w)) + ((b.x * b.x + b.y * b.y) + (b.z * b.z + b.w * b.w)); }
        if (OUT_F32) {
#pragma unroll
            for (int j = 0; j < 4; ++j)
#pragma unroll
                for (int e = 0; e < 2; ++e) *(f32x4*)(outf + (size_t)m * DM + 512 * j + 8 * lane + 4 * e) = mv[j][e];
        } else {
#pragma unroll
            for (int j = 0; j < 4; ++j) { const f32x4 a = mv[j][0], b = mv[j][1];
                v4u o; o.x = pk2(a.x, a.y); o.y = pk2(a.z, a.w); o.z = pk2(b.x, b.y); o.w = pk2(b.z, b.w);
                *(v4u*)(XRb + (size_t)m * DM + 512 * j + 8 * lane) = o; }
            const float rs2 = __builtin_amdgcn_rsqf(wave_sum(s2) * (1.f / DM) + NORM_EPS);
            if (lane == 0) RSb[m] = rs2;
        }
    }
}

__device__ __forceinline__ void cvt_rows(const float* x, bf16* XRb, float* RSb, int gw, int NGW, int lane) {
    f32x4 nv[4][2];
#pragma unroll
    for (int j = 0; j < 4; ++j)
#pragma unroll
        for (int e = 0; e < 2; ++e) nv[j][e] = *(const f32x4*)(x + (size_t)gw * DM + 512 * j + 8 * lane + 4 * e);
    for (int m = gw; m < MTOK; m += NGW) {
        f32x4 v[4][2]; float ss = 0.f;
#pragma unroll
        for (int j = 0; j < 4; ++j)
#pragma unroll
            for (int e = 0; e < 2; ++e) v[j][e] = nv[j][e];
        const int mn = m + NGW;
        if (mn < MTOK) {
#pragma unroll
            for (int j = 0; j < 4; ++j)
#pragma unroll
                for (int e = 0; e < 2; ++e) nv[j][e] = *(const f32x4*)(x + (size_t)mn * DM + 512 * j + 8 * lane + 4 * e); }
#pragma unroll
        for (int j = 0; j < 4; ++j)
#pragma unroll
            for (int e = 0; e < 2; ++e) ss += (v[j][e].x * v[j][e].x + v[j][e].y * v[j][e].y) + (v[j][e].z * v[j][e].z + v[j][e].w * v[j][e].w);
        const float r = __builtin_amdgcn_rsqf(wave_sum(ss) * (1.f / DM) + NORM_EPS);
#pragma unroll
        for (int j = 0; j < 4; ++j) { const f32x4 a = v[j][0], b = v[j][1];
            v4u o; o.x = pk2(a.x, a.y); o.y = pk2(a.z, a.w); o.z = pk2(b.x, b.y); o.w = pk2(b.z, b.w);
            *(v4u*)(XRb + (size_t)m * DM + 512 * j + 8 * lane) = o; }
        if (lane == 0) RSb[m] = r;
    }
}

__device__ __forceinline__ void mixerA_item(const bf16* proj, const float* conv_a, bf16* Y, int item, int tid) {
    const int cgp = tid & 127, tg = tid >> 7, c0 = 8 * cgp;
    const int row0 = item * 64 + tg * 16, t0 = row0 & (SEQ - 1);
    float w0[8], w1[8], w2[8], u1[8], u2[8];
#pragma unroll
    for (int e = 0; e < 8; ++e) { w0[e] = conv_a[c0 + e]; w1[e] = conv_a[1024 + c0 + e]; w2[e] = conv_a[2048 + c0 + e]; u1[e] = 0.f; u2[e] = 0.f; }
    if (t0 != 0) {
        const v4u c2 = *(const v4u*)(proj + (size_t)(row0 - 2) * DIN + 1024 + c0), x2 = *(const v4u*)(proj + (size_t)(row0 - 2) * DIN + 2048 + c0);
        const v4u c1 = *(const v4u*)(proj + (size_t)(row0 - 1) * DIN + 1024 + c0), x1 = *(const v4u*)(proj + (size_t)(row0 - 1) * DIN + 2048 + c0);
#pragma unroll
        for (int q = 0; q < 4; ++q) { u2[2 * q] = bflo(c2[q]) * bflo(x2[q]); u2[2 * q + 1] = bfhi(c2[q]) * bfhi(x2[q]); u1[2 * q] = bflo(c1[q]) * bflo(x1[q]); u1[2 * q + 1] = bfhi(c1[q]) * bfhi(x1[q]); }
    }
    for (int i0 = 0; i0 < 16; i0 += 4) {
        v4u bg[4], cgv[4], ax[4];
#pragma unroll
        for (int i = 0; i < 4; ++i) { const bf16* p = proj + (size_t)(row0 + i0 + i) * DIN + c0; bg[i] = *(const v4u*)p; cgv[i] = *(const v4u*)(p + 1024); ax[i] = *(const v4u*)(p + 2048); }
#pragma unroll
        for (int i = 0; i < 4; ++i) {
            float u0[8], y[8];
#pragma unroll
            for (int q = 0; q < 4; ++q) { u0[2 * q] = bflo(cgv[i][q]) * bflo(ax[i][q]); u0[2 * q + 1] = bfhi(cgv[i][q]) * bfhi(ax[i][q]); }
#pragma unroll
            for (int q = 0; q < 4; ++q) { y[2 * q] = bflo(bg[i][q]) * (w0[2 * q] * u2[2 * q] + w1[2 * q] * u1[2 * q] + w2[2 * q] * u0[2 * q]);
                y[2 * q + 1] = bfhi(bg[i][q]) * (w0[2 * q + 1] * u2[2 * q + 1] + w1[2 * q + 1] * u1[2 * q + 1] + w2[2 * q + 1] * u0[2 * q + 1]); }
            v4u o; o.x = pk2(y[0], y[1]); o.y = pk2(y[2], y[3]); o.z = pk2(y[4], y[5]); o.w = pk2(y[6], y[7]);
            *(v4u*)(Y + (size_t)(row0 + i0 + i) * DM + c0) = o;
#pragma unroll
            for (int e = 0; e < 8; ++e) { u2[e] = u1[e]; u1[e] = u0[e]; }
        }
    }
}

template <int SHR> __device__ __forceinline__ float dpp_shr(float oldv, float src) {
    return __builtin_bit_cast(float, __builtin_amdgcn_update_dpp(__builtin_bit_cast(int, oldv), __builtin_bit_cast(int, src), 0x110 + SHR, 0xf, 0xf, false));
}
template <int SHR> __device__ __forceinline__ void scan_step(float (&av)[16], float (&bv)[16]) {
#pragma unroll
    for (int i = 0; i < 16; ++i) { const float ap = dpp_shr<SHR>(1.f, av[i]); const float bp = dpp_shr<SHR>(0.f, bv[i]); bv[i] = av[i] * bp + bv[i]; av[i] = av[i] * ap; }
}
__device__ __forceinline__ void mixerB_item(const bf16* proj, const float* conv_b, const float* conv_b_bias, const float* w_a, const float* b_a, const float* w_x, const float* b_x,
                                            const float* lam, bf16* Y, int item, LAS unsigned char* lds, int tid) {
    const int b = item >> 4, hd = item & 15;
    const int lane = tid & 63, w = __builtin_amdgcn_readfirstlane(tid >> 6), fr = lane & 15, fq = lane >> 4;
    LAS float* cst = (LAS float*)lds;
    LAS float* agg = cst + 512;
    __syncthreads();
    { const int k = tid >> 6, c = tid & 63, ch = hd * 64 + c; float v;
      if (k < 4) v = conv_b[k * 1024 + ch]; else if (k == 4) v = conv_b_bias[ch]; else if (k == 5) v = b_a[ch]; else if (k == 6) v = b_x[ch];
      else { const float l = lam[ch]; v = 8.f * (fminf(l, 0.f) - log1pf(__expf(-fabsf(l)))); }
      cst[k * 64 + c] = v; }
    LAS unsigned char* wf = lds + 10240;
    {
#pragma unroll
        for (int q = 0; q < 2; ++q) { const int fi = w * 2 + q, mat = fi >> 3, mt = (fi >> 1) & 3, s = fi & 1; const float* wsrc = mat ? w_x : w_a; bf16x8 fragv;
#pragma unroll
            for (int jj = 0; jj < 8; ++jj) { const int idx = 8 * s + jj; const int i = 16 * (idx >> 2) + 4 * fq + (idx & 3); const int j = 16 * mt + fr;
                fragv[jj] = (short)pg8::f2bf1(wsrc[(size_t)(hd * 64 + i) * 64 + j]); }
            *(LAS bf16x8*)(wf + fi * 1024 + lane * 16) = fragv; }
    }
    __syncthreads();
    float hc[16];
#pragma unroll
    for (int i = 0; i < 16; ++i) hc[i] = 0.f;
    const bf16* pbx = proj + (size_t)(b * SEQ) * DIN + 4096 + hd * 64 + 4 * fq;
    const bf16* pgt = proj + (size_t)(b * SEQ) * DIN + 3072 + hd * 64 + 4 * fq;
    bf16* py = Y + (size_t)(b * SEQ) * DM + 1024 + hd * 64 + 4 * fq;
    v2u nraw[4][4], ngraw[4];
#define MB_LOAD(cc) do { const int t_ = (cc) * 128 + w * 16 + fr; _Pragma("unroll") for (int k = 0; k < 4; ++k) { const int tok = t_ - 3 + k; \
        _Pragma("unroll") for (int g = 0; g < 4; ++g) { nraw[k][g] = (v2u){0u, 0u}; if (tok >= 0) nraw[k][g] = *(const v2u*)(pbx + (size_t)tok * DIN + 16 * g); } } \
        _Pragma("unroll") for (int g = 0; g < 4; ++g) ngraw[g] = *(const v2u*)(pgt + (size_t)t_ * DIN + 16 * g); } while (0)
    MB_LOAD(0);
    for (int c = 0; c < SEQ / 128; ++c) {
        asm volatile("" ::: "memory");
        const int t = c * 128 + w * 16 + fr;
        v2u raw[4][4], graw[4];
#pragma unroll
        for (int k = 0; k < 4; ++k)
#pragma unroll
            for (int g = 0; g < 4; ++g) raw[k][g] = nraw[k][g];
#pragma unroll
        for (int g = 0; g < 4; ++g) graw[g] = ngraw[g];
        if (c + 1 < SEQ / 128) MB_LOAD(c + 1);
        float xr[16];
#pragma unroll
        for (int g = 0; g < 4; ++g) { f32x4 acc = *(const LAS f32x4*)(cst + 4 * 64 + 16 * g + 4 * fq);
#pragma unroll
            for (int k = 0; k < 4; ++k) { const f32x4 wk = *(const LAS f32x4*)(cst + k * 64 + 16 * g + 4 * fq);
                acc.x += wk.x * bflo(raw[k][g].x); acc.y += wk.y * bfhi(raw[k][g].x); acc.z += wk.z * bflo(raw[k][g].y); acc.w += wk.w * bfhi(raw[k][g].y); }
            xr[4 * g] = acc.x; xr[4 * g + 1] = acc.y; xr[4 * g + 2] = acc.z; xr[4 * g + 3] = acc.w; }
        bf16x8 xb[2];
#pragma unroll
        for (int s = 0; s < 2; ++s) { const unsigned p0 = pk2(xr[8 * s], xr[8 * s + 1]), p1 = pk2(xr[8 * s + 2], xr[8 * s + 3]), p2 = pk2(xr[8 * s + 4], xr[8 * s + 5]), p3 = pk2(xr[8 * s + 6], xr[8 * s + 7]);
            xb[s] = __builtin_bit_cast(bf16x8, (v4u){p0, p1, p2, p3}); }
        float av[16], bv[16];
#pragma unroll
        for (int mt = 0; mt < 4; ++mt) { f32x4 ga = {0.f, 0.f, 0.f, 0.f}, gx = {0.f, 0.f, 0.f, 0.f};
            asm volatile("" : "+v"(ga), "+v"(gx));
#pragma unroll
            for (int s = 0; s < 2; ++s) { const bf16x8 wa_ = *(const LAS bf16x8*)(wf + (mt * 2 + s) * 1024 + lane * 16), wx_ = *(const LAS bf16x8*)(wf + (8 + mt * 2 + s) * 1024 + lane * 16);
                ga = __builtin_amdgcn_mfma_f32_16x16x32_bf16(wa_, xb[s], ga, 0, 0, 0); gx = __builtin_amdgcn_mfma_f32_16x16x32_bf16(wx_, xb[s], gx, 0, 0, 0); }
            const f32x4 ba4 = *(const LAS f32x4*)(cst + 5 * 64 + 16 * mt + 4 * fq), bx4 = *(const LAS f32x4*)(cst + 6 * 64 + 16 * mt + 4 * fq), cl4 = *(const LAS f32x4*)(cst + 7 * 64 + 16 * mt + 4 * fq);
#pragma unroll
            for (int r = 0; r < 4; ++r) { const float ra = fsigmoid(ga[r] + ba4[r]), ia = fsigmoid(gx[r] + bx4[r]); const float la = cl4[r] * ra;
                const float a = __expf(la); const float m2 = fmaxf(1.f - __expf(2.f * la), 0.f);
                av[4 * mt + r] = a; bv[4 * mt + r] = __builtin_sqrtf(m2) * ia * xr[4 * mt + r]; } }
        scan_step<1>(av, bv); scan_step<2>(av, bv); scan_step<4>(av, bv); scan_step<8>(av, bv);
        LAS float* ag = agg + (c & 1) * 1024;
        if (fr == 15) {
#pragma unroll
            for (int g = 0; g < 4; ++g) { LAS float* p = ag + (w * 64 + 16 * g + 4 * fq) * 2;
                *(LAS f32x4*)p = (f32x4){av[4 * g], bv[4 * g], av[4 * g + 1], bv[4 * g + 1]}; *(LAS f32x4*)(p + 4) = (f32x4){av[4 * g + 2], bv[4 * g + 2], av[4 * g + 3], bv[4 * g + 3]}; }
        }
        LDS_BARRIER();
        float hin[16];
#pragma unroll
        for (int i = 0; i < 16; ++i) hin[i] = 0.f;
#pragma unroll
        for (int w2 = 0; w2 < 8; ++w2) {
            if (w2 == w) {
#pragma unroll
                for (int i = 0; i < 16; ++i) hin[i] = hc[i]; }
#pragma unroll
            for (int g = 0; g < 4; ++g) { const LAS float* p = ag + (w2 * 64 + 16 * g + 4 * fq) * 2; const f32x4 q0 = *(const LAS f32x4*)p, q1 = *(const LAS f32x4*)(p + 4);
                hc[4 * g] = q0.x * hc[4 * g] + q0.y; hc[4 * g + 1] = q0.z * hc[4 * g + 1] + q0.w; hc[4 * g + 2] = q1.x * hc[4 * g + 2] + q1.y; hc[4 * g + 3] = q1.z * hc[4 * g + 3] + q1.w; }
        }
#pragma unroll
        for (int g = 0; g < 4; ++g) { float y[4];
#pragma unroll
            for (int r = 0; r < 4; ++r) { const int i = 4 * g + r; const float hv = bv[i] + av[i] * hin[i];
                const float gt = (r & 1) ? bfhi(r < 2 ? graw[g].x : graw[g].y) : bflo(r < 2 ? graw[g].x : graw[g].y);
                const float inner = 1.5957691216057308f * (gt + 0.044715f * gt * gt * gt);
                y[r] = hv * gt * fsigmoid(inner); }
            *(v2u*)(py + (size_t)t * DM + 16 * g) = (v2u){pk2(y[0], y[1]), pk2(y[2], y[3])}; }
    }
}

__device__ __forceinline__ int crow(int i, int hh) { return (i & 3) + 8 * (i >> 2) + 4 * hh; }
constexpr int AK_PITCH = 272, AV_PITCH = 80, AK_BYTES = 32 * AK_PITCH, AV_BYTES = 128 * AV_PITCH, A_FLAGS = 4 * AK_BYTES + 4 * AV_BYTES;
constexpr float SB_DONE = -160.f;
__device__ __forceinline__ void att_compute(LAS unsigned char* lds, int cur, int hsel, int qi, int hh, int tq, int kt, bool diag, const bf16x8 (&qf)[8], f32x16 (&o)[4], float& carry) {
    const LAS unsigned char* kb_ = lds + (cur * 2 + hsel) * AK_BYTES; const LAS unsigned char* vb_ = lds + 4 * AK_BYTES + (cur * 2 + hsel) * AV_BYTES;
    const int key0 = 32 * kt;
    f32x16 s;
#pragma unroll
    for (int i = 0; i < 16; ++i) s[i] = 0.f;
    asm volatile("" : "+v"(s));
#pragma unroll
    for (int ks = 0; ks < 8; ++ks) { const bf16x8 kf = *(const LAS bf16x8*)(kb_ + qi * AK_PITCH + 32 * ks + 16 * hh);
        s = __builtin_amdgcn_mfma_f32_32x32x16_bf16(kf, qf[ks], s, 0, 0, 0); }
    float ln[16], lw[16];
#pragma unroll
    for (int i = 0; i < 16; ++i) { const float z = s[i]; const float tt = __builtin_amdgcn_exp2f(-fabsf(z)); const float L = fmaxf(z, 0.f) + __builtin_amdgcn_logf(1.f + tt);
        const bool valid = !diag || (key0 + crow(i, hh) < tq);
        ln[i] = valid ? -L : 0.f; lw[i] = valid ? (z - L) : -1e30f; }
    float so[4], sp[4], tot[4];
#pragma unroll
    for (int g = 0; g < 4; ++g) { so[g] = (ln[4 * g] + ln[4 * g + 1]) + (ln[4 * g + 2] + ln[4 * g + 3]); sp[g] = __shfl_xor(so[g], 32); tot[g] = so[g] + sp[g]; }
    float after[4];
    after[3] = (hh == 0) ? sp[3] : 0.f;
    after[2] = tot[3] + ((hh == 0) ? sp[2] : 0.f);
    after[1] = tot[3] + tot[2] + ((hh == 0) ? sp[1] : 0.f);
    after[0] = tot[3] + tot[2] + tot[1] + ((hh == 0) ? sp[0] : 0.f);
    float wv[16];
#pragma unroll
    for (int g = 0; g < 4; ++g) { const float x3 = carry + after[g], x2 = x3 + ln[4 * g + 3], x1 = x2 + ln[4 * g + 2], x0 = x1 + ln[4 * g + 1];
        wv[4 * g + 3] = __builtin_amdgcn_exp2f(lw[4 * g + 3] + x3); wv[4 * g + 2] = __builtin_amdgcn_exp2f(lw[4 * g + 2] + x2);
        wv[4 * g + 1] = __builtin_amdgcn_exp2f(lw[4 * g + 1] + x1); wv[4 * g] = __builtin_amdgcn_exp2f(lw[4 * g] + x0); }
    carry += (tot[0] + tot[1]) + (tot[2] + tot[3]);
    const bf16x8 pa0 = __builtin_bit_cast(bf16x8, (v4u){pk2(wv[0], wv[1]), pk2(wv[2], wv[3]), pk2(wv[4], wv[5]), pk2(wv[6], wv[7])});
    const bf16x8 pa1 = __builtin_bit_cast(bf16x8, (v4u){pk2(wv[8], wv[9]), pk2(wv[10], wv[11]), pk2(wv[12], wv[13]), pk2(wv[14], wv[15])});
#pragma unroll
    for (int dt = 0; dt < 4; ++dt) { const LAS unsigned char* vp = vb_ + (32 * dt + qi) * AV_PITCH + 16 * hh;
        const bf16x8 v0 = *(const LAS bf16x8*)vp, v1 = *(const LAS bf16x8*)(vp + 32);
        o[dt] = __builtin_amdgcn_mfma_f32_32x32x16_bf16(v0, pa0, o[dt], 0, 0, 0); o[dt] = __builtin_amdgcn_mfma_f32_32x32x16_bf16(v1, pa1, o[dt], 0, 0, 0); }
}
__device__ __forceinline__ void attn_unit(const bf16* Q, const bf16* K, const bf16* Vt, bf16* Y, int unit, LAS unsigned char* lds, int tid) {
    const int qb = unit & 31, hp = (unit >> 5) & 7, b = unit >> 8;
    const int lane = tid & 63, w = __builtin_amdgcn_readfirstlane(tid >> 6), qi = lane & 31, hh = lane >> 5;
    const int hsel = w >> 2, wl = w & 3, h = 2 * hp + hsel;
    const int q0 = qb * 128, tq = q0 + 32 * wl + qi;
    LAS int* flags = (LAS int*)(lds + A_FLAGS);
    __syncthreads();
    if (tid < 16) flags[tid] = 0;
    bf16x8 qf[8];
    { const bf16* qp = Q + (size_t)(b * SEQ + tq) * DM + h * 128 + 8 * hh;
#pragma unroll
      for (int ks = 0; ks < 8; ++ks) qf[ks] = *(const bf16x8*)(qp + 16 * ks); }
    f32x16 o[4];
#pragma unroll
    for (int dt = 0; dt < 4; ++dt)
#pragma unroll
        for (int i = 0; i < 16; ++i) o[dt][i] = 0.f;
#pragma unroll
    for (int dt = 0; dt < 4; ++dt) asm volatile("" : "+v"(o[dt]));
    float carry = 0.f; bool done = false;
    const int ktop = 4 * qb + 3, ktw = 4 * qb + wl;
    const int kkey = tid >> 4, kc = tid & 15;
    const int vd = tid >> 2, vc4 = tid & 3;
    const bf16* kg = K + (size_t)(b * SEQ + kkey) * DM + (2 * hp) * 128 + 8 * kc;
    const bf16* vg = Vt + ((size_t)((b * 16 + 2 * hp) * 128 + vd) << 12) + 8 * vc4;
    const int kdst = kkey * AK_PITCH + 16 * kc;
    const int vdst = vd * AV_PITCH + 2 * (16 * (vc4 >> 1) + 4 * (vc4 & 1));
    v4u kr[2], vr[2];
#define A_LOAD(kt) do { _Pragma("unroll") for (int i_ = 0; i_ < 2; ++i_) { kr[i_] = *(const v4u*)(kg + i_ * 128 + (size_t)(32 * (kt)) * DM); vr[i_] = *(const v4u*)(vg + ((size_t)(128 * i_) << 12) + 32 * (kt)); } } while (0)
#define A_WRITE(bufi) do { _Pragma("unroll") for (int i_ = 0; i_ < 2; ++i_) { *(LAS v4u*)(lds + ((bufi) * 2 + i_) * AK_BYTES + kdst) = kr[i_]; \
        LAS unsigned char* vp_ = lds + 4 * AK_BYTES + ((bufi) * 2 + i_) * AV_BYTES + vdst; *(LAS v2u*)vp_ = (v2u){vr[i_].x, vr[i_].y}; *(LAS v2u*)(vp_ + 16) = (v2u){vr[i_].z, vr[i_].w}; } } while (0)
    A_LOAD(ktop); A_WRITE(0);
    if (ktop > 0) A_LOAD(ktop - 1);
    v4u kr2[2], vr2[2];
#pragma unroll
    for (int i_ = 0; i_ < 2; ++i_) { kr2[i_] = kr[i_]; vr2[i_] = vr[i_]; }
    int it = 0, kt = ktop; bool fin = false;
#define ATT_STEP(KW, VW, KL, VL) do { \
        const int cur = it & 1; \
        if (kt > 1) { _Pragma("unroll") for (int i_ = 0; i_ < 2; ++i_) { KL[i_] = *(const v4u*)(kg + i_ * 128 + (size_t)(32 * (kt - 2)) * DM); VL[i_] = *(const v4u*)(vg + ((size_t)(128 * i_) << 12) + 32 * (kt - 2)); } } \
        LDS_BARRIER(); \
        if (it > 0) { const LAS int* f = flags + ((it - 1) & 1) * 8; int all = 1; _Pragma("unroll") for (int i = 0; i < 8; ++i) all &= f[i]; if (all) { fin = true; break; } } \
        if (!done && kt <= ktw) { att_compute(lds, cur, hsel, qi, hh, tq, kt, kt == ktw, qf, o, carry); done = (__builtin_amdgcn_ballot_w64(carry > SB_DONE) == 0ull); } \
        if (lane == 0) flags[cur * 8 + w] = done ? 1 : 0; \
        if (kt == 0) { fin = true; break; } \
        _Pragma("unroll") for (int i_ = 0; i_ < 2; ++i_) { *(LAS v4u*)(lds + ((cur ^ 1) * 2 + i_) * AK_BYTES + kdst) = KW[i_]; \
            LAS unsigned char* vp_ = lds + 4 * AK_BYTES + ((cur ^ 1) * 2 + i_) * AV_BYTES + vdst; *(LAS v2u*)vp_ = (v2u){VW[i_].x, VW[i_].y}; *(LAS v2u*)(vp_ + 16) = (v2u){VW[i_].z, VW[i_].w}; } \
        ++it; --kt; } while (0)
    while (!fin) { ATT_STEP(kr, vr, kr2, vr2); if (fin) break; ATT_STEP(kr2, vr2, kr, vr); }
#undef ATT_STEP
#undef A_LOAD
#undef A_WRITE
    bf16* yp = Y + (size_t)(b * SEQ + tq) * DM + h * 128 + 4 * hh;
#pragma unroll
    for (int dt = 0; dt < 4; ++dt)
#pragma unroll
        for (int g = 0; g < 4; ++g) *(v2u*)(yp + 32 * dt + 8 * g) = (v2u){pk2(o[dt][4 * g], o[dt][4 * g + 1]), pk2(o[dt][4 * g + 2], o[dt][4 * g + 3])};
}

#define XB_TMO      128
#define XB_XCNT(j)  (256  + 64 * (j))
#define XB_XSUB(j)  (1280 + 64 * (j))
#define XB_XGEN(j)  (2304 + 64 * (j))
#define XB_TOP      3328
#define XB_TOPGEN   3392
#define XCD_BAR_WORDS 3456
#define XB_SPIN_CAP (1u << 18)

__device__ __forceinline__ unsigned xb_ld(unsigned* p)              { return __hip_atomic_load(p, __ATOMIC_RELAXED, __HIP_MEMORY_SCOPE_AGENT); }
__device__ __forceinline__ unsigned xb_add(unsigned* p, unsigned v) { return __hip_atomic_fetch_add(p, v, __ATOMIC_RELAXED, __HIP_MEMORY_SCOPE_AGENT); }
__device__ __forceinline__ unsigned xb_xcc_id() { return (unsigned)__builtin_amdgcn_s_getreg((3 << 11) | 20) & 0xFu; }
#define XB_SPIN(cond, bar) do { unsigned _sp = 0; while (cond) { __builtin_amdgcn_s_sleep(1); \
    if ((++_sp & 255u) == 0u) { if (xb_ld(&(bar)[XB_TMO])) break; if (_sp > XB_SPIN_CAP) { atomicAdd(&(bar)[XB_TMO], 1u); break; } } } } while (0)

struct XcdBarrier {
    unsigned* bar; unsigned x;
    volatile LAS unsigned* st;
};

__device__ __forceinline__ XcdBarrier xcd_barrier_post(unsigned* bar, volatile LAS unsigned* st) {
    XcdBarrier b; b.bar = bar; b.x = xb_xcc_id(); b.st = st;
    if (threadIdx.x == 0) (void)xb_add(&bar[XB_XCNT(b.x)], 1u);
    return b;
}
__device__ __forceinline__ void xcd_barrier_complete(unsigned* bar, unsigned x, unsigned& nloc, unsigned& nx) {
    const unsigned G = gridDim.x * gridDim.y * gridDim.z;
    unsigned sum, cnt, mine, sp = 0u;
    for (;;) {
        sum = 0u; cnt = 0u; mine = 0u;
#pragma unroll
        for (unsigned j = 0; j < 16; ++j) { const unsigned c = xb_ld(&bar[XB_XCNT(j)]); sum += c; cnt += (c > 0u) ? 1u : 0u; mine = (j == x) ? c : mine; }
        if (sum == G) break;
        __builtin_amdgcn_s_sleep(1);
        if ((++sp & 255u) == 0u) { if (xb_ld(&bar[XB_TMO])) break; if (sp > XB_SPIN_CAP) { atomicAdd(&bar[XB_TMO], 1u); break; } }
    }
    nloc = mine > 0u ? mine : 1u; nx = cnt > 0u ? cnt : 1u;
}

__device__ __forceinline__ void xcd_barrier(const XcdBarrier& b) {
    asm volatile("s_waitcnt vmcnt(0)" ::: "memory");
    __syncthreads();
    if (threadIdx.x == 0) {
        unsigned* bar = b.bar;
        __builtin_amdgcn_s_waitcnt(0);
        unsigned nloc = b.st[0], nx = b.st[1];
        if (nloc == 0u) { xcd_barrier_complete(bar, b.x, nloc, nx); b.st[0] = nloc; b.st[1] = nx; }
        const unsigned old = xb_add(&bar[XB_XSUB(b.x)], 1u);
        const unsigned gen = old / nloc;
        if (old + 1u == (gen + 1u) * nloc) {
            __builtin_amdgcn_fence(__ATOMIC_RELEASE, "agent");
            asm volatile("s_waitcnt vmcnt(0)" ::: "memory");
            const unsigned og = xb_add(&bar[XB_TOP], 1u);
            const unsigned tg = og / nx;
            if (og + 1u == (tg + 1u) * nx) xb_add(&bar[XB_TOPGEN], 1u);
            else XB_SPIN(xb_ld(&bar[XB_TOPGEN]) == tg, bar);
            __builtin_amdgcn_fence(__ATOMIC_ACQUIRE, "agent");
            xb_add(&bar[XB_XGEN(b.x)], 1u);
            asm volatile("s_waitcnt vmcnt(0)" ::: "memory");
        } else {
            XB_SPIN(xb_ld(&bar[XB_XGEN(b.x)]) == gen, bar);
            __builtin_amdgcn_fence(__ATOMIC_ACQUIRE, "agent");
            asm volatile("s_waitcnt vmcnt(0)" ::: "memory");
        }
    }
    __syncthreads();
}

struct Args { const float* in[16]; float* out; unsigned char* ws; };
__global__ void __launch_bounds__(NTHR, 2) mega_fwd(Args args) {
    extern __shared__ __attribute__((aligned(16))) unsigned char lds_raw[];
    LAS unsigned char* lds = (LAS unsigned char*)lds_raw;
    cg::grid_group grid = cg::this_grid();
    if (threadIdx.x < 64) ((LAS unsigned*)(lds + LDS_MISC))[threadIdx.x] = 0u;
    __syncthreads();
    const XcdBarrier bar = xcd_barrier_post((unsigned*)(args.ws + WS_CTL), (volatile LAS unsigned*)(lds + LDS_MISC) + 8);
    const int G = gridDim.x, bx = blockIdx.x, NGW = G * NWAVES;
    unsigned char* ws = args.ws;
    const float* x = args.in[0]; const float* gains = args.in[1];
    bf16* Wt_in = (bf16*)(ws + WS_WIN); bf16* Wt_out = (bf16*)(ws + WS_WOUT); bf16* Wt_qkv = (bf16*)(ws + WS_WQKV); bf16* Wt_o = (bf16*)(ws + WS_WO);
    bf16* XR = (bf16*)(ws + WS_H); bf16* MIX = (bf16*)(ws + WS_MIX); bf16* BIG = (bf16*)(ws + WS_BIG); float* RS = (float*)(ws + WS_RS);
    float* out = args.out; bf16* Yb = (bf16*)args.out;

    bf16* Qb = BIG; bf16* Kb = BIG + (size_t)MTOK * DM; bf16* Vtb = BIG + 2 * (size_t)MTOK * DM;
    for (int ph = 0; ph < 15; ++ph) {
        int tid = threadIdx.x; asm volatile("" : "+v"(tid));
        const int lane = tid & 63, wave = __builtin_amdgcn_readfirstlane(tid >> 6), gw = bx * NWAVES + wave;
        const int layer = ph >= 8 ? 1 : 0;
        const float* g = gains + (size_t)layer * 4 * DM;
        int gk = -1;
        if (ph == 1 || ph == 3 || ph == 5 || ph == 6 || ph == 8 || ph == 10 || ph == 12 || ph == 13) gk = ph;
        if (gk >= 0) {
#ifndef NO_GEMM
            pg8::Gemm gm{XR, Wt_in, MTOK, DIN, DM}; pg8::EpiGen E{0, BIG, DIN, Kb, Vtb, 0.08838834764831845f * 1.4426950408889634f, RS};
            if (gk == 3) { gm.A = Yb; gm.Bt = Wt_out; gm.N = DM; E.O = MIX; E.ldc = DM; E.rowscale = nullptr; }
            else if (gk == 5 || gk == 12) { gm.Bt = (const bf16*)(ws + (gk == 12 ? WS_WUP1 : WS_WUP0)); gm.N = DFF; E.mode = 2; E.ldc = DFF; }
            else if (gk == 6 || gk == 13) { gm.A = BIG; gm.Bt = (const bf16*)(ws + (gk == 13 ? WS_WDN1 : WS_WDN0)); gm.N = DM; gm.K = DFF; E.O = MIX; E.ldc = DM; E.rowscale = nullptr; }
            else if (gk == 8) { gm.Bt = Wt_qkv; gm.N = NQKV; E.mode = 3; E.O = Qb; E.ldc = DM; }
            else if (gk == 10) { gm.A = Yb; gm.Bt = Wt_o; gm.N = DM; E.O = MIX; E.ldc = DM; E.rowscale = nullptr; }
            pg8::StaticOrder S; S.init(MTOK, gm.N, G, bx);
            pg8::gemm_phase<pg8::EpiGen, pg8::StaticOrder, true, true>(lds, gm, S, E);
#endif
        } else if (ph == 0) {
#ifndef NO_P0
            LAS float* scr = (LAS float*)(lds + wave * 16384);
            constexpr int I_IN = 32 * 160, I_OUT = 32 * 64, I_QKV = 32 * 192, I_O = 32 * 64, I_UP = 32 * 256, I_DN = 128 * 64;
            constexpr int NITEMS = I_IN + I_OUT + I_QKV + I_O + 2 * I_UP + 2 * I_DN;
            for (int it = gw; it < NITEMS; it += NGW) {
                int r = it;
                if (r < I_IN) { p0_transpose_item(args.in[2], DM, DIN, Wt_in, scr, r, lane, gains); continue; } r -= I_IN;
                if (r < I_OUT) { p0_transpose_item(args.in[11], DM, DM, Wt_out, scr, r, lane); continue; } r -= I_OUT;
                if (r < I_QKV) { p0_transpose_item(args.in[12], DM, NQKV, Wt_qkv, scr, r, lane, gains + 4 * DM); continue; } r -= I_QKV;
                if (r < I_O) { p0_transpose_item(args.in[13], DM, DM, Wt_o, scr, r, lane); continue; } r -= I_O;
                if (r < 2 * I_UP) { const int l = r / I_UP; p0_transpose_item(args.in[14] + (size_t)l * DM * DFF, DM, DFF, (bf16*)(ws + (l ? WS_WUP1 : WS_WUP0)), scr, r - l * I_UP, lane, gains + (size_t)(l * 4 + 2) * DM); continue; } r -= 2 * I_UP;
                { const int l = r / I_DN; p0_transpose_item(args.in[15] + (size_t)l * DFF * DM, DFF, DM, (bf16*)(ws + (l ? WS_WDN1 : WS_WDN0)), scr, r - l * I_DN, lane); }
            }
            cvt_rows(x, XR, RS, gw, NGW, lane);
#endif
        } else if (ph == 2) {
#ifndef NO_MIX
            constexpr int NB = BATCH * 16, NA = MTOK / 64;
            for (int it = bx; it < NB + NA; it += G) {
                if (it < NB) mixerB_item(BIG, args.in[4], args.in[5], args.in[6], args.in[7], args.in[8], args.in[9], args.in[10], Yb, it, lds, tid);
                else mixerA_item(BIG, args.in[3], Yb, it - NB, tid);
            }
#endif
        } else if (ph == 9) {
#ifndef NO_ATTN
            if (G == 256) { for (int k = 0; k < 8; ++k) attn_unit(Qb, Kb, Vtb, Yb, (((k << 3) | (bx & 7)) << 5) | (bx >> 3), lds, tid); }
            else { for (int u = bx; u < BATCH * 8 * 32; u += G) attn_unit(Qb, Kb, Vtb, Yb, u, lds, tid); }
#endif
        } else {
#ifndef NO_POST
            const float* gpost = (ph == 4 || ph == 11) ? g + DM : g + 3 * DM;
            if (ph == 14) post_rows<true>(MIX, XR, out, gpost, RS, gw, NGW, lane); else post_rows<false>(MIX, XR, out, gpost, RS, gw, NGW, lane);
#endif
        }
        if (ph == 0) grid.sync(); else if (ph < 14) xcd_barrier(bar);
    }
}

extern "C" void kernel_launch(void* const* d_in, const int* in_sizes, int n_in, void* d_out, int out_size, void* d_ws, size_t ws_size, hipStream_t stream) {
    static int grid = 0;
    if (grid == 0) {
        if (n_in != 16 || in_sizes[0] != MTOK * DM || out_size != MTOK * DM || ws_size < WS_END) { fprintf(stderr, "kernel_launch: unexpected shapes / workspace (n_in %d, ws %zu); nothing launched\n", n_in, ws_size); grid = -1; return; }
        int dev = 0, cus = 0, per_cu = 0;
        if (hipGetDevice(&dev) != hipSuccess || hipDeviceGetAttribute(&cus, hipDeviceAttributeMultiprocessorCount, dev) != hipSuccess) { grid = -1; return; }
        if (hipFuncSetAttribute((const void*)mega_fwd, hipFuncAttributeMaxDynamicSharedMemorySize, LDS_BYTES) != hipSuccess) { fprintf(stderr, "kernel_launch: hipFuncSetAttribute failed\n"); grid = -1; return; }
        if (hipOccupancyMaxActiveBlocksPerMultiprocessor(&per_cu, (const void*)mega_fwd, NTHR, LDS_BYTES) != hipSuccess || per_cu < 1) { fprintf(stderr, "kernel_launch: occupancy query says %d\n", per_cu); per_cu = 1; }
        (void)hipGetLastError();
        grid = cus;
    }
    if (grid < 0) return;
    if (hipMemsetAsync((char*)d_ws + WS_CTL, 0, CTL_BYTES, stream) != hipSuccess) { fprintf(stderr, "kernel_launch: memset of the barrier words failed\n"); return; }
    Args a{};
    for (int i = 0; i < 16; ++i) a.in[i] = (const float*)d_in[i];
    a.out = (float*)d_out; a.ws = (unsigned char*)d_ws;
    void* kargs[] = {&a};
    hipError_t e = hipLaunchCooperativeKernel((const void*)mega_fwd, dim3(grid), dim3(NTHR), kargs, LDS_BYTES, stream);
    if (e != hipSuccess) fprintf(stderr, "kernel_launch: cooperative launch failed: %s (grid %d)\n", hipGetErrorString(e), grid);
}
```

```cpp
#include <hip/hip_runtime.h>
#include <hip/hip_cooperative_groups.h>
#include <cstdio>
#include <cstdint>
namespace cg = cooperative_groups;
namespace pg8 {
#define PG8_LAS __attribute__((address_space(3)))
typedef unsigned short bf16_t;
typedef short bf16x8 __attribute__((ext_vector_type(8)));
typedef float f32x4 __attribute__((ext_vector_type(4)));
typedef unsigned u32x4 __attribute__((ext_vector_type(4)));
constexpr int BM = 256, BK = 64, HALF = 128, HTB = HALF * BK * 2  , STAGE_BYTES = 8 * HTB, NXCD = 8, WGM = 8;

__host__ __device__ __forceinline__ int lds_byte(int r, int c) { const int st = (r >> 4) * 2 + (c >> 5), rr = r & 15, cc = c & 31, ob = rr * 64 + cc * 2; return st * 1024 + (ob ^ (((ob >> 9) & 1) << 5)); }
__host__ __device__ __forceinline__ void stage_rc(int b, int& R, int& C) { const int st = b / 1024, sb = b % 1024, swz = sb ^ (((sb >> 9) & 1) << 5); R = (st >> 1) * 16 + swz / 64; C = (st & 1) * 32 + (swz % 64) / 2; }
__host__ __device__ __forceinline__ int perm32(int rho) { const int n = rho >> 4, i = rho & 15; return 8 * (i >> 2) + 4 * n + (i & 3); }

struct Unit { int pm, pn; };
struct Gemm { const bf16_t* A; const bf16_t* Bt; int M, N, K; };

struct StaticOrder {
    int nM, nN, nwg, G, c;
    __host__ __device__ void init(int M, int N, int G_, int c_) { nM = M / BM; nN = N / BM; nwg = nM * nN; G = G_; c = c_; }
    __host__ __device__ bool next(int i, Unit& u) const {
        const long L = (long)i * G + c; if (L >= nwg) return false;
        int wgid = (int)L; { const int q = nwg / NXCD, r = nwg % NXCD, xcd = wgid % NXCD, off = wgid / NXCD; wgid = (xcd < r ? xcd * (q + 1) : r * (q + 1) + (xcd - r) * q) + off; }
        const int nig = WGM * nN, gid = wgid / nig, fm = gid * WGM, gsz = (nM - fm) < WGM ? (nM - fm) : WGM;
        u.pm = fm + ((wgid % nig) % gsz); u.pn = (wgid % nig) / gsz; return true;
    }
    __device__ __forceinline__ void a_ready(const Unit&) const {}
    __device__ __forceinline__ void done(const Unit&) const {}
};
__device__ __forceinline__ unsigned cvt_pk_bf16(float lo, float hi) { unsigned r; asm volatile("v_cvt_pk_bf16_f32 %0, %1, %2" : "=v"(r) : "v"(lo), "v"(hi)); return r; }
typedef float f32x2 __attribute__((ext_vector_type(2)));
__device__ __forceinline__ unsigned short f2bf1(float f) { unsigned u = __builtin_bit_cast(unsigned, f); return (unsigned short)((u + 0x7fffu + ((u >> 16) & 1u)) >> 16); }

struct EpiGen {
    static constexpr bool PERM = true, AFTER_DRAIN = false;
    int mode; bf16_t* O; int ldc; bf16_t* K; bf16_t* Vt; float qscale; const float* rowscale;
    __device__ __forceinline__ void operator()(const f32x4 (&acc)[2][2][4][2], const Unit& u, int wr, int wc, int fr, int fq) const {
        const int t3 = u.pn >> 3;
        if (mode == 3 && t3 == 2) {
            const int cv0 = (u.pn - 16) * BM + wc * 32 + 8 * fq;
#pragma unroll
            for (int ai = 0; ai < 2; ++ai)
#pragma unroll
                for (int m = 0; m < 4; ++m) { const int r = u.pm * BM + ai * HALF + wr * 64 + m * 16 + fr; const int b = r >> 12, t = r & 4095; const float rsv = rowscale ? rowscale[r] : 1.f;
#pragma unroll
                    for (int bj = 0; bj < 2; ++bj)
#pragma unroll
                        for (int n = 0; n < 2; ++n)
#pragma unroll
                            for (int e = 0; e < 4; ++e) { const int cv = cv0 + bj * HALF + 4 * n + e; const int head = cv >> 7, d = cv & 127;
                                Vt[((size_t)((b * 16 + head) * 128 + d) << 12) + t] = f2bf1(acc[ai][bj][m][n][e] * rsv); } }
            return;
        }
        bf16_t* base = O; float sc = 1.f; int colt = u.pn * BM;
        if (mode == 3) { colt = (u.pn & 7) * BM; if (t3) base = K; else sc = qscale; }
        const bool sq = (mode == 2);
        const int row0 = u.pm * BM + wr * 64 + fr; const int col0 = colt + wc * 32 + 8 * fq;
#pragma unroll
        for (int ai = 0; ai < 2; ++ai)
#pragma unroll
            for (int m = 0; m < 4; ++m) { bf16_t* rowp = base + (size_t)(row0 + ai * HALF + m * 16) * ldc + col0; const float rsc = (rowscale ? rowscale[row0 + ai * HALF + m * 16] : 1.f) * sc;
#pragma unroll
                for (int bj = 0; bj < 2; ++bj) { f32x4 v0 = acc[ai][bj][m][0] * rsc, v1 = acc[ai][bj][m][1] * rsc;
                    if (sq) {
#pragma unroll
                        for (int e = 0; e < 4; ++e) { float a = v0[e] > 0.f ? v0[e] : 0.f; v0[e] = a * a; float b = v1[e] > 0.f ? v1[e] : 0.f; v1[e] = b * b; } }
                    u32x4 w; w.x = cvt_pk_bf16(v0[0], v0[1]); w.y = cvt_pk_bf16(v0[2], v0[3]); w.z = cvt_pk_bf16(v1[0], v1[1]); w.w = cvt_pk_bf16(v1[2], v1[3]);
                    *(u32x4*)(rowp + bj * HALF) = w; } }
    }
};

template <class Epi, class Sched, bool ALIGN_EPI = false, bool SP2 = false>
__device__ __forceinline__ void gemm_phase(PG8_LAS unsigned char* lds, const Gemm g, const Sched& S, const Epi& E) {
    int tid = threadIdx.x; asm volatile("" : "+v"(tid)); const int wid = __builtin_amdgcn_readfirstlane(tid >> 6), lane = tid & 63, wr = wid >> 2, wc = wid & 3, fr = lane & 15, fq = lane >> 4;
    const int K = g.K, nt = K / BK;
    unsigned voffA[2], voffB[2];
#pragma unroll
    for (int i = 0; i < 2; ++i) { int R, C; stage_rc(tid * 16 + i * 8192, R, C); const int Rb = Epi::PERM ? ((R & ~31) + perm32(R & 31)) : R;
        voffA[i] = (unsigned)(R * K + C) * 2u; voffB[i] = (unsigned)(Rb * K + C) * 2u; }
    const size_t kstep = (size_t)(BK * 2);
    const size_t hstep = (size_t)HALF * K * 2;
    const size_t tstep = 2 * hstep;
    const unsigned ldsw = (unsigned)wid * 1024u;
    const int aoff = lds_byte(wr * 64 + fr, fq * 8), boff = lds_byte(wc * 32 + fr, fq * 8);
#define PG8_SA(b, h) (((b) * 2 + (h)) * HTB)
#define PG8_SB(b, h) ((4 + (b) * 2 + (h)) * HTB)
#define PG8_STAGE(bufoff, gbase, voff) do { _Pragma("unroll") for (int _i = 0; _i < 2; ++_i) \
        __builtin_amdgcn_global_load_lds((const unsigned*)((const char*)(gbase) + (voff)[_i]), (PG8_LAS unsigned*)(lds + (bufoff) + ldsw + _i * 8192), 16, 0, 0); } while (0)
#define PG8_LDA(dst, b, h) do { _Pragma("unroll") for (int m = 0; m < 4; ++m) _Pragma("unroll") for (int k = 0; k < 2; ++k) dst[m][k] = *(const PG8_LAS bf16x8*)(lds + PG8_SA(b, h) + aoff + m * 2048 + k * 1024); } while (0)
#define PG8_LDB(dst, b, h) do { _Pragma("unroll") for (int n = 0; n < 2; ++n) _Pragma("unroll") for (int k = 0; k < 2; ++k) dst[n][k] = *(const PG8_LAS bf16x8*)(lds + PG8_SB(b, h) + boff + n * 2048 + k * 1024); } while (0)
#define PG8_MMA(ai, bj, At, Bt) do { __builtin_amdgcn_s_setprio(1); _Pragma("unroll") for (int m = 0; m < 4; ++m) _Pragma("unroll") for (int n = 0; n < 2; ++n) _Pragma("unroll") for (int k = 0; k < 2; ++k) \
        acc[ai][bj][m][n] = __builtin_amdgcn_mfma_f32_16x16x32_bf16(Bt[n][k], At[m][k], acc[ai][bj][m][n], 0, 0, 0); __builtin_amdgcn_s_setprio(0); } while (0)
#define PG8_WAIT_V(n) asm volatile("s_waitcnt vmcnt(" #n ")" ::: "memory")
#define PG8_WAIT_L(n) asm volatile("s_waitcnt lgkmcnt(" #n ")" ::: "memory")
#define PG8_BAR __builtin_amdgcn_s_barrier()
#define PG8_SCHED __builtin_amdgcn_sched_barrier(0)
    Unit cur, nxt; int ui = 0;
    if (!S.next(0, cur)) return;
    f32x4 acc[2][2][4][2];
#pragma unroll
    for (int a = 0; a < 2; ++a)
#pragma unroll
        for (int b = 0; b < 2; ++b)
#pragma unroll
            for (int m = 0; m < 4; ++m)
#pragma unroll
                for (int n = 0; n < 2; ++n) acc[a][b][m][n] = (f32x4){0.f, 0.f, 0.f, 0.f};
    bf16x8 At[4][2], B0[2][2], B1[2][2];
    const char* cA = (const char*)g.A + (size_t)cur.pm * tstep; const char* cB = (const char*)g.Bt + (size_t)cur.pn * tstep;
    S.a_ready(cur);
    if constexpr (SP2) {
        PG8_STAGE(PG8_SB(0, 0), cB, voffB); PG8_STAGE(PG8_SB(0, 1), cB + hstep, voffB); PG8_STAGE(PG8_SA(0, 0), cA, voffA); PG8_STAGE(PG8_SA(0, 1), cA + hstep, voffA);
        if (wr == 1) PG8_BAR;
        PG8_WAIT_V(2); PG8_BAR;
        PG8_STAGE(PG8_SB(1, 0), cB + kstep, voffB); PG8_STAGE(PG8_SA(1, 0), cA + kstep, voffA); PG8_STAGE(PG8_SB(1, 1), cB + hstep + kstep, voffB);
        PG8_WAIT_V(6); PG8_BAR;
    } else {
        PG8_STAGE(PG8_SB(0, 0), cB, voffB); PG8_STAGE(PG8_SA(0, 0), cA, voffA); PG8_STAGE(PG8_SB(0, 1), cB + hstep, voffB); PG8_STAGE(PG8_SA(0, 1), cA + hstep, voffA);
        if (wr == 1) PG8_BAR;
        PG8_WAIT_V(4); PG8_BAR;
        PG8_STAGE(PG8_SB(1, 0), cB + kstep, voffB); PG8_STAGE(PG8_SA(1, 0), cA + kstep, voffA); PG8_STAGE(PG8_SB(1, 1), cB + hstep + kstep, voffB);
        PG8_WAIT_V(6); PG8_BAR;
    }
    for (;;) {
        const bool has_next = S.next(ui + 1, nxt);
        const char* nA = has_next ? (const char*)g.A + (size_t)nxt.pm * tstep : cA; const char* nB = has_next ? (const char*)g.Bt + (size_t)nxt.pn * tstep : cB;
        for (int t = 0; t < nt; t += 2) {
            const bool last = (t == nt - 2);
            const char* a1 = cA + (size_t)(t + 1) * kstep;
            const char* a2 = last ? nA : cA + (size_t)(t + 2) * kstep; const char* b2 = last ? nB : cB + (size_t)(t + 2) * kstep;
            const char* a3 = a2 + kstep; const char* b3 = b2 + kstep;
            if (last && has_next) S.a_ready(nxt);
            if constexpr (SP2) {
            PG8_LDB(B0, 0, 0); PG8_LDB(B1, 0, 1); PG8_SCHED; PG8_LDA(At, 0, 0); PG8_STAGE(PG8_SA(1, 1), a1 + hstep, voffA);
            PG8_WAIT_V(8); PG8_WAIT_L(0); PG8_BAR; PG8_MMA(0, 0, At, B0); PG8_MMA(0, 1, At, B1); PG8_BAR; PG8_SCHED;
            PG8_LDA(At, 0, 1); PG8_STAGE(PG8_SB(0, 0), b2, voffB); PG8_STAGE(PG8_SB(0, 1), b2 + hstep, voffB); PG8_STAGE(PG8_SA(0, 0), a2, voffA);
            PG8_WAIT_V(8); PG8_WAIT_L(0); PG8_BAR; PG8_MMA(1, 0, At, B0); PG8_MMA(1, 1, At, B1); PG8_BAR; PG8_SCHED;
            PG8_LDB(B0, 1, 0); PG8_LDB(B1, 1, 1); PG8_SCHED; PG8_LDA(At, 1, 0); PG8_STAGE(PG8_SA(0, 1), a2 + hstep, voffA);
            PG8_WAIT_V(8); PG8_WAIT_L(0); PG8_BAR; PG8_MMA(0, 0, At, B0); PG8_MMA(0, 1, At, B1); PG8_BAR; PG8_SCHED;
            PG8_LDA(At, 1, 1); PG8_STAGE(PG8_SB(1, 0), b3, voffB); PG8_STAGE(PG8_SB(1, 1), b3 + hstep, voffB); PG8_STAGE(PG8_SA(1, 0), a3, voffA);
            PG8_WAIT_V(8); PG8_WAIT_L(0); PG8_BAR; PG8_MMA(1, 0, At, B0); PG8_MMA(1, 1, At, B1); PG8_BAR; PG8_SCHED;
            } else {
            PG8_LDB(B0, 0, 0); PG8_SCHED; PG8_LDA(At, 0, 0); PG8_STAGE(PG8_SA(1, 1), a1 + hstep, voffA);
            PG8_WAIT_L(8); PG8_BAR; PG8_WAIT_L(0); PG8_MMA(0, 0, At, B0); PG8_BAR; PG8_SCHED;
            PG8_LDB(B1, 0, 1); PG8_STAGE(PG8_SB(0, 0), b2, voffB);
            PG8_BAR; PG8_WAIT_L(0); PG8_MMA(0, 1, At, B1); PG8_BAR;
            PG8_LDA(At, 0, 1); PG8_STAGE(PG8_SA(0, 0), a2, voffA);
            PG8_BAR; PG8_WAIT_L(0); PG8_MMA(1, 0, At, B0); PG8_BAR; PG8_SCHED;
            PG8_STAGE(PG8_SB(0, 1), b2 + hstep, voffB);
            PG8_WAIT_V(6); PG8_BAR; PG8_MMA(1, 1, At, B1); PG8_BAR;
            PG8_LDB(B0, 1, 0); PG8_SCHED; PG8_LDA(At, 1, 0); PG8_STAGE(PG8_SA(0, 1), a2 + hstep, voffA);
            PG8_WAIT_L(8); PG8_BAR; PG8_WAIT_L(0); PG8_MMA(0, 0, At, B0); PG8_BAR; PG8_SCHED;
            PG8_LDB(B1, 1, 1); PG8_STAGE(PG8_SB(1, 0), b3, voffB);
            PG8_BAR; PG8_WAIT_L(0); PG8_MMA(0, 1, At, B1); PG8_BAR;
            PG8_LDA(At, 1, 1); PG8_STAGE(PG8_SA(1, 0), a3, voffA);
            PG8_BAR; PG8_WAIT_L(0); PG8_MMA(1, 0, At, B0); PG8_BAR; PG8_SCHED;
            PG8_STAGE(PG8_SB(1, 1), b3 + hstep, voffB);
            PG8_WAIT_V(6); PG8_BAR; PG8_MMA(1, 1, At, B1); PG8_BAR;
            }
        }
        if constexpr (ALIGN_EPI) { if (wr == 0) PG8_BAR; }
        if constexpr (!Epi::AFTER_DRAIN) { E(acc, cur, wr, wc, fr, fq); S.done(cur); }
        if (!has_next) break;
#pragma unroll
        for (int a = 0; a < 2; ++a)
#pragma unroll
            for (int b = 0; b < 2; ++b)
#pragma unroll
                for (int m = 0; m < 4; ++m)
#pragma unroll
                    for (int n = 0; n < 2; ++n) acc[a][b][m][n] = (f32x4){0.f, 0.f, 0.f, 0.f};
        cur = nxt; cA = nA; cB = nB; ++ui;
        if constexpr (ALIGN_EPI) { if (wr == 1) PG8_BAR; }
    }
    PG8_WAIT_V(0);
    if constexpr (!ALIGN_EPI) { if (wr == 0) PG8_BAR; }
    PG8_BAR;
    if constexpr (Epi::AFTER_DRAIN) { E.fused(acc, cur, wr, wc, fr, fq, lds, wid, lane); S.done(cur); }
#undef PG8_SA
#undef PG8_SB
#undef PG8_STAGE
#undef PG8_LDA
#undef PG8_LDB
#undef PG8_MMA
#undef PG8_WAIT_V
#undef PG8_WAIT_L
#undef PG8_BAR
#undef PG8_SCHED
}
}
#define LAS __attribute__((address_space(3)))
typedef unsigned short bf16;
typedef unsigned v4u __attribute__((ext_vector_type(4)));
typedef unsigned v2u __attribute__((ext_vector_type(2)));
typedef float f32x4 __attribute__((ext_vector_type(4)));
typedef float f32x16 __attribute__((ext_vector_type(16)));
typedef short bf16x8 __attribute__((ext_vector_type(8)));
constexpr int NWAVES = 8, NTHR = 512;
constexpr int BATCH = 8, SEQ = 4096, DM = 2048, MTOK = BATCH * SEQ, DIN = 5120, DFF = 8192, NQKV = 6144;
constexpr float NORM_EPS = 1e-6f;
constexpr size_t MiB = 1u << 20;
constexpr size_t WS_WIN = 0, WS_WOUT = 20 * MiB, WS_WQKV = 28 * MiB, WS_WO = 52 * MiB, WS_WUP0 = 60 * MiB, WS_WUP1 = 92 * MiB, WS_WDN0 = 124 * MiB, WS_WDN1 = 156 * MiB;
constexpr size_t WS_H = 192 * MiB, WS_MIX = 320 * MiB, WS_BIG = 448 * MiB, WS_CTL = 960 * MiB, CTL_BYTES = 16384, WS_RS = 960 * MiB + 65536, WS_END = 961 * MiB;
constexpr int LDS_MISC = 131072, LDS_BYTES = 131072 + 256;

__device__ __forceinline__ float bflo(unsigned u) { return __uint_as_float(u << 16); }
__device__ __forceinline__ float bfhi(unsigned u) { return __uint_as_float(u & 0xffff0000u); }
__device__ __forceinline__ unsigned pk2(float lo, float hi) { return pg8::cvt_pk_bf16(lo, hi); }
__device__ __forceinline__ float wave_sum(float v) {
#pragma unroll
    for (int o = 1; o < 64; o <<= 1) v += __shfl_xor(v, o);
    return v;
}
#define LDS_BARRIER() do { asm volatile("s_waitcnt lgkmcnt(0)" ::: "memory"); __builtin_amdgcn_s_barrier(); asm volatile("" ::: "memory"); } while (0)
__device__ __forceinline__ float fsigmoid(float x) { return __builtin_amdgcn_rcpf(1.f + __expf(-x)); }

__device__ __forceinline__ void p0_transpose_item(const float* W, int K, int N, bf16* WT, LAS float* scr, int item, int lane, const float* gk = nullptr) {
    const int nblk = N / 32, kb = item / nblk, nb = item % nblk, k0 = 64 * kb, n0 = 32 * nb;
    float tv[32];
#pragma unroll
    for (int i = 0; i < 32; ++i) tv[i] = W[(size_t)(k0 + 2 * i + (lane >> 5)) * N + n0 + (lane & 31)];
#pragma unroll
    for (int i = 0; i < 32; ++i) scr[(2 * i + (lane >> 5)) * 33 + (lane & 31)] = tv[i];
    asm volatile("s_waitcnt lgkmcnt(0)" ::: "memory");
    const int c = lane & 7;
    f32x4 g0 = {1.f, 1.f, 1.f, 1.f}, g1 = {1.f, 1.f, 1.f, 1.f};
    if (gk) { g0 = *(const f32x4*)(gk + k0 + 8 * c); g1 = *(const f32x4*)(gk + k0 + 8 * c + 4); }
#pragma unroll
    for (int j = 0; j < 4; ++j) { const int n = (lane >> 3) + 8 * j; const LAS float* s = scr + (8 * c) * 33 + n;
        v4u o; o.x = pk2(s[0 * 33] * g0.x, s[1 * 33] * g0.y); o.y = pk2(s[2 * 33] * g0.z, s[3 * 33] * g0.w); o.z = pk2(s[4 * 33] * g1.x, s[5 * 33] * g1.y); o.w = pk2(s[6 * 33] * g1.z, s[7 * 33] * g1.w);
        *(v4u*)(WT + (size_t)(n0 + n) * K + k0 + 8 * c) = o; }
    asm volatile("s_waitcnt lgkmcnt(0)" ::: "memory");
}

__device__ __forceinline__ void cvt_row(const float* xrow, bf16* orow, float* rs, int lane) {
    f32x4 v[4][2]; float ss = 0.f;
#pragma unroll
    for (int j = 0; j < 4; ++j)
#pragma unroll
        for (int e = 0; e < 2; ++e) { v[j][e] = *(const f32x4*)(xrow + 512 * j + 8 * lane + 4 * e); ss += (v[j][e].x * v[j][e].x + v[j][e].y * v[j][e].y) + (v[j][e].z * v[j][e].z + v[j][e].w * v[j][e].w); }
    const float r = __builtin_amdgcn_rsqf(wave_sum(ss) * (1.f / DM) + NORM_EPS);
#pragma unroll
    for (int j = 0; j < 4; ++j) { const f32x4 a = v[j][0], b = v[j][1];
        v4u o; o.x = pk2(a.x, a.y); o.y = pk2(a.z, a.w); o.z = pk2(b.x, b.y); o.w = pk2(b.z, b.w);
        *(v4u*)(orow + 512 * j + 8 * lane) = o; }
    if (lane == 0) *rs = r;
}

template <bool XIN_F32, bool OUT_F32>
__device__ __forceinline__ void post_row(const bf16* mrow, const float* xin_f, const bf16* xin_b, float* xout_f, bf16* xout_b, const float* gpost, float* rs, int lane) {
    f32x4 mv[4][2], xv[4][2], gp[4][2]; float ss = 0.f;
    v4u r[4], xr[4];
#pragma unroll
    for (int j = 0; j < 4; ++j) r[j] = *(const v4u*)(mrow + 512 * j + 8 * lane);
    if (XIN_F32) {
#pragma unroll
        for (int j = 0; j < 4; ++j)
#pragma unroll
            for (int e = 0; e < 2; ++e) xv[j][e] = *(const f32x4*)(xin_f + 512 * j + 8 * lane + 4 * e);
    } else {
#pragma unroll
        for (int j = 0; j < 4; ++j) xr[j] = *(const v4u*)(xin_b + 512 * j + 8 * lane);
#pragma unroll
        for (int j = 0; j < 4; ++j) { xv[j][0] = (f32x4){bflo(xr[j].x), bfhi(xr[j].x), bflo(xr[j].y), bfhi(xr[j].y)}; xv[j][1] = (f32x4){bflo(xr[j].z), bfhi(xr[j].z), bflo(xr[j].w), bfhi(xr[j].w)}; }
    }
#pragma unroll
    for (int j = 0; j < 4; ++j)
#pragma unroll
        for (int e = 0; e < 2; ++e) gp[j][e] = *(const f32x4*)(gpost + 512 * j + 8 * lane + 4 * e);
#pragma unroll
    for (int j = 0; j < 4; ++j) {
        mv[j][0] = (f32x4){bflo(r[j].x), bfhi(r[j].x), bflo(r[j].y), bfhi(r[j].y)}; mv[j][1] = (f32x4){bflo(r[j].z), bfhi(r[j].z), bflo(r[j].w), bfhi(r[j].w)};
#pragma unroll
        for (int e = 0; e < 2; ++e) ss += (mv[j][e].x * mv[j][e].x + mv[j][e].y * mv[j][e].y) + (mv[j][e].z * mv[j][e].z + mv[j][e].w * mv[j][e].w); }
    const float rs1 = __builtin_amdgcn_rsqf(wave_sum(ss) * (1.f / DM) + NORM_EPS);
    float s2 = 0.f;
#pragma unroll
    for (int j = 0; j < 4; ++j)
#pragma unroll
        for (int e = 0; e < 2; ++e) { const f32x4 x1 = xv[j][e] + mv[j][e] * rs1 * gp[j][e]; mv[j][e] = x1; s2 += (x1.x * x1.x + x1.y * x1.y) + (x1.z * x1.z + x1.w * x1.w); }
    if (OUT_F32) {
#pragma unroll
        for (int j = 0; j < 4; ++j)
#pragma unroll
            for (int e = 0; e < 2; ++e) *(f32x4*)(xout_f + 512 * j + 8 * lane + 4 * e) = mv[j][e];
    } else {
#pragma unroll
        for (int j = 0; j < 4; ++j) { const f32x4 a = mv[j][0], b = mv[j][1];
            v4u o; o.x = pk2(a.x, a.y); o.y = pk2(a.z, a.w); o.z = pk2(b.x, b.y); o.w = pk2(b.z, b.w);
            *(v4u*)(xout_b + 512 * j + 8 * lane) = o; }
        const float rs2 = __builtin_amdgcn_rsqf(wave_sum(s2) * (1.f / DM) + NORM_EPS);
        if (lane == 0) *rs = rs2;
    }
}

template <bool OUT_F32>
__device__ __forceinline__ void post_rows(const bf16* MIXb, bf16* XRb, float* outf, const float* gpost, float* RSb, int gw, int NGW, int lane) {
    f32x4 gp[4][2];
#pragma unroll
    for (int j = 0; j < 4; ++j)
#pragma unroll
        for (int e = 0; e < 2; ++e) gp[j][e] = *(const f32x4*)(gpost + 512 * j + 8 * lane + 4 * e);
    v4u nr[4], nx[4];
#pragma unroll
    for (int j = 0; j < 4; ++j) { nr[j] = *(const v4u*)(MIXb + (size_t)gw * DM + 512 * j + 8 * lane); nx[j] = *(const v4u*)(XRb + (size_t)gw * DM + 512 * j + 8 * lane); }
    for (int m = gw; m < MTOK; m += NGW) {
        v4u r[4], xr[4];
#pragma unroll
        for (int j = 0; j < 4; ++j) { r[j] = nr[j]; xr[j] = nx[j]; }
        const int mn = m + NGW;
        if (mn < MTOK) {
#pragma unroll
            for (int j = 0; j < 4; ++j) { nr[j] = *(const v4u*)(MIXb + (size_t)mn * DM + 512 * j + 8 * lane); nx[j] = *(const v4u*)(XRb + (size_t)mn * DM + 512 * j + 8 * lane); } }
        f32x4 mv[4][2]; float ss = 0.f;
#pragma unroll
        for (int j = 0; j < 4; ++j) {
            mv[j][0] = (f32x4){bflo(r[j].x), bfhi(r[j].x), bflo(r[j].y), bfhi(r[j].y)}; mv[j][1] = (f32x4){bflo(r[j].z), bfhi(r[j].z), bflo(r[j].w), bfhi(r[j].w)};
#pragma unroll
            for (int e = 0; e < 2; ++e) ss += (mv[j][e].x * mv[j][e].x + mv[j][e].y * mv[j][e].y) + (mv[j][e].z * mv[j][e].z + mv[j][e].w * mv[j][e].w); }
        const float rs1 = __builtin_amdgcn_rsqf(wave_sum(ss) * (1.f / DM) + NORM_EPS);
        float s2 = 0.f;
#pragma unroll
        for (int j = 0; j < 4; ++j) {
            const f32x4 x0 = (f32x4){bflo(xr[j].x), bfhi(xr[j].x), bflo(xr[j].y), bfhi(xr[j].y)}, x1 = (f32x4){bflo(xr[j].z), bfhi(xr[j].z), bflo(xr[j].w), bfhi(xr[j].w)};
            const f32x4 a = x0 + mv[j][0] * rs1 * gp[j][0], b = x1 + mv[j][1] * rs1 * gp[j][1]; mv[j][0] = a; mv[j][1] = b;
            s2 += ((a.x * a.x + a.y * a.y) + (a.z * a.z + a.w * a.w)) + ((b.x * b.x + b.y * b.y) + (b.z * b.z + b.w * b.w)); }
        if (OUT_F32) {
#pragma unroll
            for (int j = 0; j < 4; ++j)
#pragma unroll
                for (int e = 0; e < 2; ++e) *(f32x4*)(outf + (size_t)m * DM + 512 * j + 8 * lane + 4 * e) = mv[j][e];
        } else {
#pragma unroll
            for (int j = 0; j < 4; ++j) { const f32x4 a = mv[j][0], b = mv[j][1];
                v4u o; o.x = pk2(a.x, a.y); o.y = pk2(a.z, a.w); o.z = pk2(b.x, b.y); o.w = pk2(b.z, b.w);
                *(v4u*)(XRb + (size_t)m * DM + 512 * j + 8 * lane) = o; }
            const float rs2 = __builtin_amdgcn_rsqf(wave_sum(s2) * (1.f / DM) + NORM_EPS);
            if (lane == 0) RSb[m] = rs2;
        }
    }
}

__device__ __forceinline__ void cvt_rows(const float* x, bf16* XRb, float* RSb, int gw, int NGW, int lane) {
    f32x4 nv[4][2];
#pragma unroll
    for (int j = 0; j < 4; ++j)
#pragma unroll
        for (int e = 0; e < 2; ++e) nv[j][e] = *(const f32x4*)(x + (size_t)gw * DM + 512 * j + 8 * lane + 4 * e);
    for (int m = gw; m < MTOK; m += NGW) {
        f32x4 v[4][2]; float ss = 0.f;
#pragma unroll
        for (int j = 0; j < 4; ++j)
#pragma unroll
            for (int e = 0; e < 2; ++e) v[j][e] = nv[j][e];
        const int mn = m + NGW;
        if (mn < MTOK) {
#pragma unroll
            for (int j = 0; j < 4; ++j)
#pragma unroll
                for (int e = 0; e < 2; ++e) nv[j][e] = *(const f32x4*)(x + (size_t)mn * DM + 512 * j + 8 * lane + 4 * e); }
#pragma unroll
        for (int j = 0; j < 4; ++j)
#pragma unroll
            for (int e = 0; e < 2; ++e) ss += (v[j][e].x * v[j][e].x + v[j][e].y * v[j][e].y) + (v[j][e].z * v[j][e].z + v[j][e].w * v[j][e].w);
        const float r = __builtin_amdgcn_rsqf(wave_sum(ss) * (1.f / DM) + NORM_EPS);
#pragma unroll
        for (int j = 0; j < 4; ++j) { const f32x4 a = v[j][0], b = v[j][1];
            v4u o; o.x = pk2(a.x, a.y); o.y = pk2(a.z, a.w); o.z = pk2(b.x, b.y); o.w = pk2(b.z, b.w);
            *(v4u*)(XRb + (size_t)m * DM + 512 * j + 8 * lane) = o; }
        if (lane == 0) RSb[m] = r;
    }
}

__device__ __forceinline__ void mixerA_item(const bf16* proj, const float* conv_a, bf16* Y, int item, int tid) {
    const int cgp = tid & 127, tg = tid >> 7, c0 = 8 * cgp;
    const int row0 = item * 64 + tg * 16, t0 = row0 & (SEQ - 1);
    float w0[8], w1[8], w2[8], u1[8], u2[8];
#pragma unroll
    for (int e = 0; e < 8; ++e) { w0[e] = conv_a[c0 + e]; w1[e] = conv_a[1024 + c0 + e]; w2[e] = conv_a[2048 + c0 + e]; u1[e] = 0.f; u2[e] = 0.f; }
    if (t0 != 0) {
        const v4u c2 = *(const v4u*)(proj + (size_t)(row0 - 2) * DIN + 1024 + c0), x2 = *(const v4u*)(proj + (size_t)(row0 - 2) * DIN + 2048 + c0);
        const v4u c1 = *(const v4u*)(proj + (size_t)(row0 - 1) * DIN + 1024 + c0), x1 = *(const v4u*)(proj + (size_t)(row0 - 1) * DIN + 2048 + c0);
#pragma unroll
        for (int q = 0; q < 4; ++q) { u2[2 * q] = bflo(c2[q]) * bflo(x2[q]); u2[2 * q + 1] = bfhi(c2[q]) * bfhi(x2[q]); u1[2 * q] = bflo(c1[q]) * bflo(x1[q]); u1[2 * q + 1] = bfhi(c1[q]) * bfhi(x1[q]); }
    }
    for (int i0 = 0; i0 < 16; i0 += 4) {
        v4u bg[4], cgv[4], ax[4];
#pragma unroll
        for (int i = 0; i < 4; ++i) { const bf16* p = proj + (size_t)(row0 + i0 + i) * DIN + c0; bg[i] = *(const v4u*)p; cgv[i] = *(const v4u*)(p + 1024); ax[i] = *(const v4u*)(p + 2048); }
#pragma unroll
        for (int i = 0; i < 4; ++i) {
            float u0[8], y[8];
#pragma unroll
            for (int q = 0; q < 4; ++q) { u0[2 * q] = bflo(cgv[i][q]) * bflo(ax[i][q]); u0[2 * q + 1] = bfhi(cgv[i][q]) * bfhi(ax[i][q]); }
#pragma unroll
            for (int q = 0; q < 4; ++q) { y[2 * q] = bflo(bg[i][q]) * (w0[2 * q] * u2[2 * q] + w1[2 * q] * u1[2 * q] + w2[2 * q] * u0[2 * q]);
                y[2 * q + 1] = bfhi(bg[i][q]) * (w0[2 * q + 1] * u2[2 * q + 1] + w1[2 * q + 1] * u1[2 * q + 1] + w2[2 * q + 1] * u0[2 * q + 1]); }
            v4u o; o.x = pk2(y[0], y[1]); o.y = pk2(y[2], y[3]); o.z = pk2(y[4], y[5]); o.w = pk2(y[6], y[7]);
            *(v4u*)(Y + (size_t)(row0 + i0 + i) * DM + c0) = o;
#pragma unroll
            for (int e = 0; e < 8; ++e) { u2[e] = u1[e]; u1[e] = u0[e]; }
        }
    }
}

template <int SHR> __device__ __forceinline__ float dpp_shr(float oldv, float src) {
    return __builtin_bit_cast(float, __builtin_amdgcn_update_dpp(__builtin_bit_cast(int, oldv), __builtin_bit_cast(int, src), 0x110 + SHR, 0xf, 0xf, false));
}
template <int SHR> __device__ __forceinline__ void scan_step(float (&av)[16], float (&bv)[16]) {
#pragma unroll
    for (int i = 0; i < 16; ++i) { const float ap = dpp_shr<SHR>(1.f, av[i]); const float bp = dpp_shr<SHR>(0.f, bv[i]); bv[i] = av[i] * bp + bv[i]; av[i] = av[i] * ap; }
}
__device__ __forceinline__ void mixerB_item(const bf16* proj, const float* conv_b, const float* conv_b_bias, const float* w_a, const float* b_a, const float* w_x, const float* b_x,
                                            const float* lam, bf16* Y, int item, LAS unsigned char* lds, int tid) {
    const int b = item >> 4, hd = item & 15;
    const int lane = tid & 63, w = __builtin_amdgcn_readfirstlane(tid >> 6), fr = lane & 15, fq = lane >> 4;
    LAS float* cst = (LAS float*)lds;
    LAS float* agg = cst + 512;
    __syncthreads();
    { const int k = tid >> 6, c = tid & 63, ch = hd * 64 + c; float v;
      if (k < 4) v = conv_b[k * 1024 + ch]; else if (k == 4) v = conv_b_bias[ch]; else if (k == 5) v = b_a[ch]; else if (k == 6) v = b_x[ch];
      else { const float l = lam[ch]; v = 8.f * (fminf(l, 0.f) - log1pf(__expf(-fabsf(l)))); }
      cst[k * 64 + c] = v; }
    LAS unsigned char* wf = lds + 10240;
    {
#pragma unroll
        for (int q = 0; q < 2; ++q) { const int fi = w * 2 + q, mat = fi >> 3, mt = (fi >> 1) & 3, s = fi & 1; const float* wsrc = mat ? w_x : w_a; bf16x8 fragv;
#pragma unroll
            for (int jj = 0; jj < 8; ++jj) { const int idx = 8 * s + jj; const int i = 16 * (idx >> 2) + 4 * fq + (idx & 3); const int j = 16 * mt + fr;
                fragv[jj] = (short)pg8::f2bf1(wsrc[(size_t)(hd * 64 + i) * 64 + j]); }
            *(LAS bf16x8*)(wf + fi * 1024 + lane * 16) = fragv; }
    }
    __syncthreads();
    float hc[16];
#pragma unroll
    for (int i = 0; i < 16; ++i) hc[i] = 0.f;
    const bf16* pbx = proj + (size_t)(b * SEQ) * DIN + 4096 + hd * 64 + 4 * fq;
    const bf16* pgt = proj + (size_t)(b * SEQ) * DIN + 3072 + hd * 64 + 4 * fq;
    bf16* py = Y + (size_t)(b * SEQ) * DM + 1024 + hd * 64 + 4 * fq;
    v2u nraw[4][4], ngraw[4];
#define MB_LOAD(cc) do { const int t_ = (cc) * 128 + w * 16 + fr; _Pragma("unroll") for (int k = 0; k < 4; ++k) { const int tok = t_ - 3 + k; \
        _Pragma("unroll") for (int g = 0; g < 4; ++g) { nraw[k][g] = (v2u){0u, 0u}; if (tok >= 0) nraw[k][g] = *(const v2u*)(pbx + (size_t)tok * DIN + 16 * g); } } \
        _Pragma("unroll") for (int g = 0; g < 4; ++g) ngraw[g] = *(const v2u*)(pgt + (size_t)t_ * DIN + 16 * g); } while (0)
    MB_LOAD(0);
    for (int c = 0; c < SEQ / 128; ++c) {
        asm volatile("" ::: "memory");
        const int t = c * 128 + w * 16 + fr;
        v2u raw[4][4], graw[4];
#pragma unroll
        for (int k = 0; k < 4; ++k)
#pragma unroll
            for (int g = 0; g < 4; ++g) raw[k][g] = nraw[k][g];
#pragma unroll
        for (int g = 0; g < 4; ++g) graw[g] = ngraw[g];
        if (c + 1 < SEQ / 128) MB_LOAD(c + 1);
        float xr[16];
#pragma unroll
        for (int g = 0; g < 4; ++g) { f32x4 acc = *(const LAS f32x4*)(cst + 4 * 64 + 16 * g + 4 * fq);
#pragma unroll
            for (int k = 0; k < 4; ++k) { const f32x4 wk = *(const LAS f32x4*)(cst + k * 64 + 16 * g + 4 * fq);
                acc.x += wk.x * bflo(raw[k][g].x); acc.y += wk.y * bfhi(raw[k][g].x); acc.z += wk.z * bflo(raw[k][g].y); acc.w += wk.w * bfhi(raw[k][g].y); }
            xr[4 * g] = acc.x; xr[4 * g + 1] = acc.y; xr[4 * g + 2] = acc.z; xr[4 * g + 3] = acc.w; }
        bf16x8 xb[2];
#pragma unroll
        for (int s = 0; s < 2; ++s) { const unsigned p0 = pk2(xr[8 * s], xr[8 * s + 1]), p1 = pk2(xr[8 * s + 2], xr[8 * s + 3]), p2 = pk2(xr[8 * s + 4], xr[8 * s + 5]), p3 = pk2(xr[8 * s + 6], xr[8 * s + 7]);
            xb[s] = __builtin_bit_cast(bf16x8, (v4u){p0, p1, p2, p3}); }
        float av[16], bv[16];
#pragma unroll
        for (int mt = 0; mt < 4; ++mt) { f32x4 ga = {0.f, 0.f, 0.f, 0.f}, gx = {0.f, 0.f, 0.f, 0.f};
            asm volatile("" : "+v"(ga), "+v"(gx));
#pragma unroll
            for (int s = 0; s < 2; ++s) { const bf16x8 wa_ = *(const LAS bf16x8*)(wf + (mt * 2 + s) * 1024 + lane * 16), wx_ = *(const LAS bf16x8*)(wf + (8 + mt * 2 + s) * 1024 + lane * 16);
                ga = __builtin_amdgcn_mfma_f32_16x16x32_bf16(wa_, xb[s], ga, 0, 0, 0); gx = __builtin_amdgcn_mfma_f32_16x16x32_bf16(wx_, xb[s], gx, 0, 0, 0); }
            const f32x4 ba4 = *(const LAS f32x4*)(cst + 5 * 64 + 16 * mt + 4 * fq), bx4 = *(const LAS f32x4*)(cst + 6 * 64 + 16 * mt + 4 * fq), cl4 = *(const LAS f32x4*)(cst + 7 * 64 + 16 * mt + 4 * fq);
#pragma unroll
            for (int r = 0; r < 4; ++r) { const float ra = fsigmoid(ga[r] + ba4[r]), ia = fsigmoid(gx[r] + bx4[r]); const float la = cl4[r] * ra;
                const float a = __expf(la); const float m2 = fmaxf(1.f - __expf(2.f * la), 0.f);
                av[4 * mt + r] = a; bv[4 * mt + r] = __builtin_amdgcn_sqrtf(m2) * ia * xr[4 * mt + r]; } }
        scan_step<1>(av, bv); scan_step<2>(av, bv); scan_step<4>(av, bv); scan_step<8>(av, bv);
        LAS float* ag = agg + (c & 1) * 1024;
        if (fr == 15) {
#pragma unroll
            for (int g = 0; g < 4; ++g) { LAS float* p = ag + (w * 64 + 16 * g + 4 * fq) * 2;
                *(LAS f32x4*)p = (f32x4){av[4 * g], bv[4 * g], av[4 * g + 1], bv[4 * g + 1]}; *(LAS f32x4*)(p + 4) = (f32x4){av[4 * g + 2], bv[4 * g + 2], av[4 * g + 3], bv[4 * g + 3]}; }
        }
        LDS_BARRIER();
        float hin[16];
#pragma unroll
        for (int i = 0; i < 16; ++i) hin[i] = 0.f;
#pragma unroll
        for (int w2 = 0; w2 < 8; ++w2) {
            if (w2 == w) {
#pragma unroll
                for (int i = 0; i < 16; ++i) hin[i] = hc[i]; }
#pragma unroll
            for (int g = 0; g < 4; ++g) { const LAS float* p = ag + (w2 * 64 + 16 * g + 4 * fq) * 2; const f32x4 q0 = *(const LAS f32x4*)p, q1 = *(const LAS f32x4*)(p + 4);
                hc[4 * g] = q0.x * hc[4 * g] + q0.y; hc[4 * g + 1] = q0.z * hc[4 * g + 1] + q0.w; hc[4 * g + 2] = q1.x * hc[4 * g + 2] + q1.y; hc[4 * g + 3] = q1.z * hc[4 * g + 3] + q1.w; }
        }
#pragma unroll
        for (int g = 0; g < 4; ++g) { float y[4];
#pragma unroll
            for (int r = 0; r < 4; ++r) { const int i = 4 * g + r; const float hv = bv[i] + av[i] * hin[i];
                const float gt = (r & 1) ? bfhi(r < 2 ? graw[g].x : graw[g].y) : bflo(r < 2 ? graw[g].x : graw[g].y);
                const float inner = 1.5957691216057308f * (gt + 0.044715f * gt * gt * gt);
                y[r] = hv * gt * fsigmoid(inner); }
            *(v2u*)(py + (size_t)t * DM + 16 * g) = (v2u){pk2(y[0], y[1]), pk2(y[2], y[3])}; }
    }
}

__device__ __forceinline__ int crow(int i, int hh) { return (i & 3) + 8 * (i >> 2) + 4 * hh; }
constexpr int AK_PITCH = 272, AV_PITCH = 80, AK_BYTES = 32 * AK_PITCH, AV_BYTES = 128 * AV_PITCH, A_FLAGS = 4 * AK_BYTES + 4 * AV_BYTES;
constexpr float SB_DONE = -160.f;
__device__ __forceinline__ void att_compute(LAS unsigned char* lds, int cur, int hsel, int qi, int hh, int tq, int kt, bool diag, const bf16x8 (&qf)[8], f32x16 (&o)[4], float& carry) {
    const LAS unsigned char* kb_ = lds + (cur * 2 + hsel) * AK_BYTES; const LAS unsigned char* vb_ = lds + 4 * AK_BYTES + (cur * 2 + hsel) * AV_BYTES;
    const int key0 = 32 * kt;
    f32x16 s;
#pragma unroll
    for (int i = 0; i < 16; ++i) s[i] = 0.f;
    asm volatile("" : "+v"(s));
#pragma unroll
    for (int ks = 0; ks < 8; ++ks) { const bf16x8 kf = *(const LAS bf16x8*)(kb_ + qi * AK_PITCH + 32 * ks + 16 * hh);
        s = __builtin_amdgcn_mfma_f32_32x32x16_bf16(kf, qf[ks], s, 0, 0, 0); }
    float ln[16], lw[16];
#pragma unroll
    for (int i = 0; i < 16; ++i) { const float z = s[i]; const float tt = __builtin_amdgcn_exp2f(-fabsf(z)); const float L = fmaxf(z, 0.f) + __builtin_amdgcn_logf(1.f + tt);
        const bool valid = !diag || (key0 + crow(i, hh) < tq);
        ln[i] = valid ? -L : 0.f; lw[i] = valid ? (z - L) : -1e30f; }
    float so[4], sp[4], tot[4];
#pragma unroll
    for (int g = 0; g < 4; ++g) { so[g] = (ln[4 * g] + ln[4 * g + 1]) + (ln[4 * g + 2] + ln[4 * g + 3]); sp[g] = __shfl_xor(so[g], 32); tot[g] = so[g] + sp[g]; }
    float after[4];
    after[3] = (hh == 0) ? sp[3] : 0.f;
    after[2] = tot[3] + ((hh == 0) ? sp[2] : 0.f);
    after[1] = tot[3] + tot[2] + ((hh == 0) ? sp[1] : 0.f);
    after[0] = tot[3] + tot[2] + tot[1] + ((hh == 0) ? sp[0] : 0.f);
    float wv[16];
#pragma unroll
    for (int g = 0; g < 4; ++g) { const float x3 = carry + after[g], x2 = x3 + ln[4 * g + 3], x1 = x2 + ln[4 * g + 2], x0 = x1 + ln[4 * g + 1];
        wv[4 * g + 3] = __builtin_amdgcn_exp2f(lw[4 * g + 3] + x3); wv[4 * g + 2] = __builtin_amdgcn_exp2f(lw[4 * g + 2] + x2);
        wv[4 * g + 1] = __builtin_amdgcn_exp2f(lw[4 * g + 1] + x1); wv[4 * g] = __builtin_amdgcn_exp2f(lw[4 * g] + x0); }
    carry += (tot[0] + tot[1]) + (tot[2] + tot[3]);
    const bf16x8 pa0 = __builtin_bit_cast(bf16x8, (v4u){pk2(wv[0], wv[1]), pk2(wv[2], wv[3]), pk2(wv[4], wv[5]), pk2(wv[6], wv[7])});
    const bf16x8 pa1 = __builtin_bit_cast(bf16x8, (v4u){pk2(wv[8], wv[9]), pk2(wv[10], wv[11]), pk2(wv[12], wv[13]), pk2(wv[14], wv[15])});
#pragma unroll
    for (int dt = 0; dt < 4; ++dt) { const LAS unsigned char* vp = vb_ + (32 * dt + qi) * AV_PITCH + 16 * hh;
        const bf16x8 v0 = *(const LAS bf16x8*)vp, v1 = *(const LAS bf16x8*)(vp + 32);
        o[dt] = __builtin_amdgcn_mfma_f32_32x32x16_bf16(v0, pa0, o[dt], 0, 0, 0); o[dt] = __builtin_amdgcn_mfma_f32_32x32x16_bf16(v1, pa1, o[dt], 0, 0, 0); }
}
__device__ __forceinline__ void attn_unit(const bf16* Q, const bf16* K, const bf16* Vt, bf16* Y, int unit, LAS unsigned char* lds, int tid) {
    const int qb = unit & 31, hp = (unit >> 5) & 7, b = unit >> 8;
    const int lane = tid & 63, w = __builtin_amdgcn_readfirstlane(tid >> 6), qi = lane & 31, hh = lane >> 5;
    const int hsel = w >> 2, wl = w & 3, h = 2 * hp + hsel;
    const int q0 = qb * 128, tq = q0 + 32 * wl + qi;
    LAS int* flags = (LAS int*)(lds + A_FLAGS);
    __syncthreads();
    if (tid < 16) flags[tid] = 0;
    bf16x8 qf[8];
    { const bf16* qp = Q + (size_t)(b * SEQ + tq) * DM + h * 128 + 8 * hh;
#pragma unroll
      for (int ks = 0; ks < 8; ++ks) qf[ks] = *(const bf16x8*)(qp + 16 * ks); }
    f32x16 o[4];
#pragma unroll
    for (int dt = 0; dt < 4; ++dt)
#pragma unroll
        for (int i = 0; i < 16; ++i) o[dt][i] = 0.f;
#pragma unroll
    for (int dt = 0; dt < 4; ++dt) asm volatile("" : "+v"(o[dt]));
    float carry = 0.f; bool done = false;
    const int ktop = 4 * qb + 3, ktw = 4 * qb + wl;
    const int kkey = tid >> 4, kc = tid & 15;
    const int vd = tid >> 2, vc4 = tid & 3;
    const bf16* kg = K + (size_t)(b * SEQ + kkey) * DM + (2 * hp) * 128 + 8 * kc;
    const bf16* vg = Vt + ((size_t)((b * 16 + 2 * hp) * 128 + vd) << 12) + 8 * vc4;
    const int kdst = kkey * AK_PITCH + 16 * kc;
    const int vdst = vd * AV_PITCH + 2 * (16 * (vc4 >> 1) + 4 * (vc4 & 1));
    v4u kr[2], vr[2];
#define A_LOAD(kt) do { _Pragma("unroll") for (int i_ = 0; i_ < 2; ++i_) { kr[i_] = *(const v4u*)(kg + i_ * 128 + (size_t)(32 * (kt)) * DM); vr[i_] = *(const v4u*)(vg + ((size_t)(128 * i_) << 12) + 32 * (kt)); } } while (0)
#define A_WRITE(bufi) do { _Pragma("unroll") for (int i_ = 0; i_ < 2; ++i_) { *(LAS v4u*)(lds + ((bufi) * 2 + i_) * AK_BYTES + kdst) = kr[i_]; \
        LAS unsigned char* vp_ = lds + 4 * AK_BYTES + ((bufi) * 2 + i_) * AV_BYTES + vdst; *(LAS v2u*)vp_ = (v2u){vr[i_].x, vr[i_].y}; *(LAS v2u*)(vp_ + 16) = (v2u){vr[i_].z, vr[i_].w}; } } while (0)
    A_LOAD(ktop); A_WRITE(0);
    if (ktop > 0) A_LOAD(ktop - 1);
    v4u kr2[2], vr2[2];
#pragma unroll
    for (int i_ = 0; i_ < 2; ++i_) { kr2[i_] = kr[i_]; vr2[i_] = vr[i_]; }
    int it = 0, kt = ktop; bool fin = false;
#define ATT_STEP(KW, VW, KL, VL) do { \
        const int cur = it & 1; \
        if (kt > 1) { _Pragma("unroll") for (int i_ = 0; i_ < 2; ++i_) { KL[i_] = *(const v4u*)(kg + i_ * 128 + (size_t)(32 * (kt - 2)) * DM); VL[i_] = *(const v4u*)(vg + ((size_t)(128 * i_) << 12) + 32 * (kt - 2)); } } \
        LDS_BARRIER(); \
        if (it > 0) { const LAS int* f = flags + ((it - 1) & 1) * 8; int all = 1; _Pragma("unroll") for (int i = 0; i < 8; ++i) all &= f[i]; if (all) { fin = true; break; } } \
        if (!done && kt <= ktw) { att_compute(lds, cur, hsel, qi, hh, tq, kt, kt == ktw, qf, o, carry); done = (__builtin_amdgcn_ballot_w64(carry > SB_DONE) == 0ull); } \
        if (lane == 0) flags[cur * 8 + w] = done ? 1 : 0; \
        if (kt == 0) { fin = true; break; } \
        _Pragma("unroll") for (int i_ = 0; i_ < 2; ++i_) { *(LAS v4u*)(lds + ((cur ^ 1) * 2 + i_) * AK_BYTES + kdst) = KW[i_]; \
            LAS unsigned char* vp_ = lds + 4 * AK_BYTES + ((cur ^ 1) * 2 + i_) * AV_BYTES + vdst; *(LAS v2u*)vp_ = (v2u){VW[i_].x, VW[i_].y}; *(LAS v2u*)(vp_ + 16) = (v2u){VW[i_].z, VW[i_].w}; } \
        ++it; --kt; } while (0)
    while (!fin) { ATT_STEP(kr, vr, kr2, vr2); if (fin) break; ATT_STEP(kr2, vr2, kr, vr); }
#undef ATT_STEP
#undef A_LOAD
#undef A_WRITE
    bf16* yp = Y + (size_t)(b * SEQ + tq) * DM + h * 128 + 4 * hh;
#pragma unroll
    for (int dt = 0; dt < 4; ++dt)
#pragma unroll
        for (int g = 0; g < 4; ++g) *(v2u*)(yp + 32 * dt + 8 * g) = (v2u){pk2(o[dt][4 * g], o[dt][4 * g + 1]), pk2(o[dt][4 * g + 2], o[dt][4 * g + 3])};
}

#define XB_TMO      128
#define XB_XCNT(j)  (256  + 64 * (j))
#define XB_XSUB(j)  (1280 + 64 * (j))
#define XB_XGEN(j)  (2304 + 64 * (j))
#define XB_TOP      3328
#define XB_TOPGEN   3392
#define XCD_BAR_WORDS 3456
#define XB_SPIN_CAP (1u << 18)

__device__ __forceinline__ unsigned xb_ld(unsigned* p)              { return __hip_atomic_load(p, __ATOMIC_RELAXED, __HIP_MEMORY_SCOPE_AGENT); }
__device__ __forceinline__ unsigned xb_add(unsigned* p, unsigned v) { return __hip_atomic_fetch_add(p, v, __ATOMIC_RELAXED, __HIP_MEMORY_SCOPE_AGENT); }
__device__ __forceinline__ unsigned xb_xcc_id() { return (unsigned)__builtin_amdgcn_s_getreg((3 << 11) | 20) & 0xFu; }
#define XB_SPIN(cond, bar) do { unsigned _sp = 0; while (cond) { __builtin_amdgcn_s_sleep(1); \
    if ((++_sp & 255u) == 0u) { if (xb_ld(&(bar)[XB_TMO])) break; if (_sp > XB_SPIN_CAP) { atomicAdd(&(bar)[XB_TMO], 1u); break; } } } } while (0)

struct XcdBarrier {
    unsigned* bar; unsigned x;
    volatile LAS unsigned* st;
};

__device__ __forceinline__ XcdBarrier xcd_barrier_post(unsigned* bar, volatile LAS unsigned* st) {
    XcdBarrier b; b.bar = bar; b.x = xb_xcc_id(); b.st = st;
    if (threadIdx.x == 0) (void)xb_add(&bar[XB_XCNT(b.x)], 1u);
    return b;
}
__device__ __forceinline__ void xcd_barrier_complete(unsigned* bar, unsigned x, unsigned& nloc, unsigned& nx) {
    const unsigned G = gridDim.x * gridDim.y * gridDim.z;
    unsigned sum, cnt, mine, sp = 0u;
    for (;;) {
        sum = 0u; cnt = 0u; mine = 0u;
#pragma unroll
        for (unsigned j = 0; j < 16; ++j) { const unsigned c = xb_ld(&bar[XB_XCNT(j)]); sum += c; cnt += (c > 0u) ? 1u : 0u; mine = (j == x) ? c : mine; }
        if (sum == G) break;
        __builtin_amdgcn_s_sleep(1);
        if ((++sp & 255u) == 0u) { if (xb_ld(&bar[XB_TMO])) break; if (sp > XB_SPIN_CAP) { atomicAdd(&bar[XB_TMO], 1u); break; } }
    }
    nloc = mine > 0u ? mine : 1u; nx = cnt > 0u ? cnt : 1u;
}

__device__ __forceinline__ void xcd_barrier(const XcdBarrier& b) {
    asm volatile("s_waitcnt vmcnt(0)" ::: "memory");
    __syncthreads();
    if (threadIdx.x == 0) {
        unsigned* bar = b.bar;
        __builtin_amdgcn_s_waitcnt(0);
        unsigned nloc = b.st[0], nx = b.st[1];
        if (nloc == 0u) { xcd_barrier_complete(bar, b.x, nloc, nx); b.st[0] = nloc; b.st[1] = nx; }
        const unsigned old = xb_add(&bar[XB_XSUB(b.x)], 1u);
        const unsigned gen = old / nloc;
        if (old + 1u == (gen + 1u) * nloc) {
            __builtin_amdgcn_fence(__ATOMIC_RELEASE, "agent");
            asm volatile("s_waitcnt vmcnt(0)" ::: "memory");
            const unsigned og = xb_add(&bar[XB_TOP], 1u);
            const unsigned tg = og / nx;
            if (og + 1u == (tg + 1u) * nx) xb_add(&bar[XB_TOPGEN], 1u);
            else XB_SPIN(xb_ld(&bar[XB_TOPGEN]) == tg, bar);
            __builtin_amdgcn_fence(__ATOMIC_ACQUIRE, "agent");
            xb_add(&bar[XB_XGEN(b.x)], 1u);
            asm volatile("s_waitcnt vmcnt(0)" ::: "memory");
        } else {
            XB_SPIN(xb_ld(&bar[XB_XGEN(b.x)]) == gen, bar);
            __builtin_amdgcn_fence(__ATOMIC_ACQUIRE, "agent");
            asm volatile("s_waitcnt vmcnt(0)" ::: "memory");
        }
    }
    __syncthreads();
}

struct Args { const float* in[16]; float* out; unsigned char* ws; };
__global__ void __launch_bounds__(NTHR, 2) mega_fwd(Args args) {
    extern __shared__ __attribute__((aligned(16))) unsigned char lds_raw[];
    LAS unsigned char* lds = (LAS unsigned char*)lds_raw;
    cg::grid_group grid = cg::this_grid();
    if (threadIdx.x < 64) ((LAS unsigned*)(lds + LDS_MISC))[threadIdx.x] = 0u;
    __syncthreads();
    const XcdBarrier bar = xcd_barrier_post((unsigned*)(args.ws + WS_CTL), (volatile LAS unsigned*)(lds + LDS_MISC) + 8);
    const int G = gridDim.x, bx = blockIdx.x, NGW = G * NWAVES;
    unsigned char* ws = args.ws;
    const float* x = args.in[0]; const float* gains = args.in[1];
    bf16* Wt_in = (bf16*)(ws + WS_WIN); bf16* Wt_out = (bf16*)(ws + WS_WOUT); bf16* Wt_qkv = (bf16*)(ws + WS_WQKV); bf16* Wt_o = (bf16*)(ws + WS_WO);
    bf16* XR = (bf16*)(ws + WS_H); bf16* MIX = (bf16*)(ws + WS_MIX); bf16* BIG = (bf16*)(ws + WS_BIG); float* RS = (float*)(ws + WS_RS);
    float* out = args.out; bf16* Yb = (bf16*)args.out;

    bf16* Qb = BIG; bf16* Kb = BIG + (size_t)MTOK * DM; bf16* Vtb = BIG + 2 * (size_t)MTOK * DM;
    for (int ph = 0; ph < 15; ++ph) {
        int tid = threadIdx.x; asm volatile("" : "+v"(tid));
        const int lane = tid & 63, wave = __builtin_amdgcn_readfirstlane(tid >> 6), gw = bx * NWAVES + wave;
        const int layer = ph >= 8 ? 1 : 0;
        const float* g = gains + (size_t)layer * 4 * DM;
        int gk = -1;
        if (ph == 1 || ph == 3 || ph == 5 || ph == 6 || ph == 8 || ph == 10 || ph == 12 || ph == 13) gk = ph;
        if (gk >= 0) {
#ifndef NO_GEMM
            pg8::Gemm gm{XR, Wt_in, MTOK, DIN, DM}; pg8::EpiGen E{0, BIG, DIN, Kb, Vtb, 0.08838834764831845f * 1.4426950408889634f, RS};
            if (gk == 3) { gm.A = Yb; gm.Bt = Wt_out; gm.N = DM; E.O = MIX; E.ldc = DM; E.rowscale = nullptr; }
            else if (gk == 5 || gk == 12) { gm.Bt = (const bf16*)(ws + (gk == 12 ? WS_WUP1 : WS_WUP0)); gm.N = DFF; E.mode = 2; E.ldc = DFF; }
            else if (gk == 6 || gk == 13) { gm.A = BIG; gm.Bt = (const bf16*)(ws + (gk == 13 ? WS_WDN1 : WS_WDN0)); gm.N = DM; gm.K = DFF; E.O = MIX; E.ldc = DM; E.rowscale = nullptr; }
            else if (gk == 8) { gm.Bt = Wt_qkv; gm.N = NQKV; E.mode = 3; E.O = Qb; E.ldc = DM; }
            else if (gk == 10) { gm.A = Yb; gm.Bt = Wt_o; gm.N = DM; E.O = MIX; E.ldc = DM; E.rowscale = nullptr; }
            pg8::StaticOrder S; S.init(MTOK, gm.N, G, bx);
            pg8::gemm_phase<pg8::EpiGen, pg8::StaticOrder, true, true>(lds, gm, S, E);
#endif
        } else if (ph == 0) {
#ifndef NO_P0
            LAS float* scr = (LAS float*)(lds + wave * 16384);
            constexpr int I_IN = 32 * 160, I_OUT = 32 * 64, I_UP = 32 * 256, I_DN = 128 * 64;
            constexpr int NITEMS = I_IN + I_OUT + I_UP + I_DN;
            for (int it = gw; it < NITEMS; it += NGW) {
                int r = it;
                if (r < I_IN) { p0_transpose_item(args.in[2], DM, DIN, Wt_in, scr, r, lane, gains); continue; } r -= I_IN;
                if (r < I_OUT) { p0_transpose_item(args.in[11], DM, DM, Wt_out, scr, r, lane); continue; } r -= I_OUT;
                if (r < I_UP) { p0_transpose_item(args.in[14], DM, DFF, (bf16*)(ws + WS_WUP0), scr, r, lane, gains + 2 * DM); continue; } r -= I_UP;
                p0_transpose_item(args.in[15], DFF, DM, (bf16*)(ws + WS_WDN0), scr, r, lane);
            }
            cvt_rows(x, XR, RS, gw, NGW, lane);
#endif
        } else if (ph == 2) {
#ifndef NO_MIX
            constexpr int NB = BATCH * 16, NA = MTOK / 64;
            for (int it = bx; it < NB + NA; it += G) {
                if (it < NB) mixerB_item(BIG, args.in[4], args.in[5], args.in[6], args.in[7], args.in[8], args.in[9], args.in[10], Yb, it, lds, tid);
                else mixerA_item(BIG, args.in[3], Yb, it - NB, tid);
            }
            {
                const int first = (G > NB) ? NB : 0;
                if (bx >= first) {
                    __syncthreads();
                    LAS float* scr = (LAS float*)(lds + wave * 16384);
                    constexpr int I_QKV = 32 * 192, I_O = 32 * 64, I_UP = 32 * 256, I_DN = 128 * 64;
                    const int gw2 = (bx - first) * NWAVES + wave, NGW2 = (G - first) * NWAVES;
                    for (int it = gw2; it < I_QKV + I_O + I_UP + I_DN; it += NGW2) {
                        int r = it;
                        if (r < I_QKV) { p0_transpose_item(args.in[12], DM, NQKV, Wt_qkv, scr, r, lane, gains + 4 * DM); continue; } r -= I_QKV;
                        if (r < I_O) { p0_transpose_item(args.in[13], DM, DM, Wt_o, scr, r, lane); continue; } r -= I_O;
                        if (r < I_UP) { p0_transpose_item(args.in[14] + (size_t)DM * DFF, DM, DFF, (bf16*)(ws + WS_WUP1), scr, r, lane, gains + 6 * DM); continue; } r -= I_UP;
                        p0_transpose_item(args.in[15] + (size_t)DFF * DM, DFF, DM, (bf16*)(ws + WS_WDN1), scr, r, lane);
                    }
                }
            }
#endif
        } else if (ph == 9) {
#ifndef NO_ATTN
            if (G == 256) { for (int k = 0; k < 8; ++k) attn_unit(Qb, Kb, Vtb, Yb, (((k << 3) | (bx & 7)) << 5) | (bx >> 3), lds, tid); }
            else { for (int u = bx; u < BATCH * 8 * 32; u += G) attn_unit(Qb, Kb, Vtb, Yb, u, lds, tid); }
#endif
        } else {
#ifndef NO_POST
            const float* gpost = (ph == 4 || ph == 11) ? g + DM : g + 3 * DM;
            if (ph == 14) post_rows<true>(MIX, XR, out, gpost, RS, gw, NGW, lane); else post_rows<false>(MIX, XR, out, gpost, RS, gw, NGW, lane);
#endif
        }
        if (ph == 0) grid.sync(); else if (ph < 14) xcd_barrier(bar);
    }
}

extern "C" void kernel_launch(void* const* d_in, const int* in_sizes, int n_in, void* d_out, int out_size, void* d_ws, size_t ws_size, hipStream_t stream) {
    static int grid = 0;
    if (grid == 0) {
        if (n_in != 16 || in_sizes[0] != MTOK * DM || out_size != MTOK * DM || ws_size < WS_END) { fprintf(stderr, "kernel_launch: unexpected shapes / workspace (n_in %d, ws %zu); nothing launched\n", n_in, ws_size); grid = -1; return; }
        int dev = 0, cus = 0, per_cu = 0;
        if (hipGetDevice(&dev) != hipSuccess || hipDeviceGetAttribute(&cus, hipDeviceAttributeMultiprocessorCount, dev) != hipSuccess) { grid = -1; return; }
        if (hipFuncSetAttribute((const void*)mega_fwd, hipFuncAttributeMaxDynamicSharedMemorySize, LDS_BYTES) != hipSuccess) { fprintf(stderr, "kernel_launch: hipFuncSetAttribute failed\n"); grid = -1; return; }
        if (hipOccupancyMaxActiveBlocksPerMultiprocessor(&per_cu, (const void*)mega_fwd, NTHR, LDS_BYTES) != hipSuccess || per_cu < 1) { fprintf(stderr, "kernel_launch: occupancy query says %d\n", per_cu); per_cu = 1; }
        (void)hipGetLastError();
        grid = cus;
    }
    if (grid < 0) return;
    if (hipMemsetAsync((char*)d_ws + WS_CTL, 0, CTL_BYTES, stream) != hipSuccess) { fprintf(stderr, "kernel_launch: memset of the barrier words failed\n"); return; }
    Args a{};
    for (int i = 0; i < 16; ++i) a.in[i] = (const float*)d_in[i];
    a.out = (float*)d_out; a.ws = (unsigned char*)d_ws;
    void* kargs[] = {&a};
    hipError_t e = hipLaunchCooperativeKernel((const void*)mega_fwd, dim3(grid), dim3(NTHR), kargs, LDS_BYTES, stream);
    if (e != hipSuccess) fprintf(stderr, "kernel_launch: cooperative launch failed: %s (grid %d)\n", hipGetErrorString(e), grid);
}
```

```cpp
#include <hip/hip_runtime.h>
#include <hip/hip_cooperative_groups.h>
#include <cstdio>
#include <cstdint>
namespace cg = cooperative_groups;
namespace pg8 {
#define PG8_LAS __attribute__((address_space(3)))
typedef unsigned short bf16_t;
typedef short bf16x8 __attribute__((ext_vector_type(8)));
typedef float f32x4 __attribute__((ext_vector_type(4)));
typedef unsigned u32x4 __attribute__((ext_vector_type(4)));
constexpr int BM = 256, BK = 64, HALF = 128, HTB = HALF * BK * 2  , STAGE_BYTES = 8 * HTB, NXCD = 8, WGM = 8;

__host__ __device__ __forceinline__ int lds_byte(int r, int c) { const int st = (r >> 4) * 2 + (c >> 5), rr = r & 15, cc = c & 31, ob = rr * 64 + cc * 2; return st * 1024 + (ob ^ (((ob >> 9) & 1) << 5)); }
__host__ __device__ __forceinline__ void stage_rc(int b, int& R, int& C) { const int st = b / 1024, sb = b % 1024, swz = sb ^ (((sb >> 9) & 1) << 5); R = (st >> 1) * 16 + swz / 64; C = (st & 1) * 32 + (swz % 64) / 2; }
__host__ __device__ __forceinline__ int perm32(int rho) { const int n = rho >> 4, i = rho & 15; return 8 * (i >> 2) + 4 * n + (i & 3); }

struct Unit { int pm, pn; };
struct Gemm { const bf16_t* A; const bf16_t* Bt; int M, N, K; };

struct StaticOrder {
    int nM, nN, nwg, G, c;
    __host__ __device__ void init(int M, int N, int G_, int c_) { nM = M / BM; nN = N / BM; nwg = nM * nN; G = G_; c = c_; }
    __host__ __device__ bool next(int i, Unit& u) const {
        const long L = (long)i * G + c; if (L >= nwg) return false;
        int wgid = (int)L; { const int q = nwg / NXCD, r = nwg % NXCD, xcd = wgid % NXCD, off = wgid / NXCD; wgid = (xcd < r ? xcd * (q + 1) : r * (q + 1) + (xcd - r) * q) + off; }
        const int nig = WGM * nN, gid = wgid / nig, fm = gid * WGM, gsz = (nM - fm) < WGM ? (nM - fm) : WGM;
        u.pm = fm + ((wgid % nig) % gsz); u.pn = (wgid % nig) / gsz; return true;
    }
    __device__ __forceinline__ void a_ready(const Unit&) const {}
    __device__ __forceinline__ void done(const Unit&) const {}
};
__device__ __forceinline__ unsigned cvt_pk_bf16(float lo, float hi) { unsigned r; asm volatile("v_cvt_pk_bf16_f32 %0, %1, %2" : "=v"(r) : "v"(lo), "v"(hi)); return r; }
typedef float f32x2 __attribute__((ext_vector_type(2)));
__device__ __forceinline__ unsigned short f2bf1(float f) { unsigned u = __builtin_bit_cast(unsigned, f); return (unsigned short)((u + 0x7fffu + ((u >> 16) & 1u)) >> 16); }

struct EpiGen {
    static constexpr bool PERM = true, AFTER_DRAIN = false;
    int mode; bf16_t* O; int ldc; bf16_t* K; bf16_t* Vt; float qscale; const float* rowscale;
    __device__ __forceinline__ void operator()(const f32x4 (&acc)[2][2][4][2], const Unit& u, int wr, int wc, int fr, int fq) const {
        const int t3 = u.pn >> 3;
        if (mode == 3 && t3 == 2) {
            const int cv0 = (u.pn - 16) * BM + wc * 32 + 8 * fq;
#pragma unroll
            for (int ai = 0; ai < 2; ++ai)
#pragma unroll
                for (int m = 0; m < 4; ++m) { const int r = u.pm * BM + ai * HALF + wr * 64 + m * 16 + fr; const int b = r >> 12, t = r & 4095; const float rsv = rowscale ? rowscale[r] : 1.f;
#pragma unroll
                    for (int bj = 0; bj < 2; ++bj)
#pragma unroll
                        for (int n = 0; n < 2; ++n)
#pragma unroll
                            for (int e = 0; e < 4; ++e) { const int cv = cv0 + bj * HALF + 4 * n + e; const int head = cv >> 7, d = cv & 127;
                                Vt[((size_t)((b * 16 + head) * 128 + d) << 12) + t] = f2bf1(acc[ai][bj][m][n][e] * rsv); } }
            return;
        }
        bf16_t* base = O; float sc = 1.f; int colt = u.pn * BM;
        if (mode == 3) { colt = (u.pn & 7) * BM; if (t3) base = K; else sc = qscale; }
        const bool sq = (mode == 2);
        const int row0 = u.pm * BM + wr * 64 + fr; const int col0 = colt + wc * 32 + 8 * fq;
#pragma unroll
        for (int ai = 0; ai < 2; ++ai)
#pragma unroll
            for (int m = 0; m < 4; ++m) { bf16_t* rowp = base + (size_t)(row0 + ai * HALF + m * 16) * ldc + col0; const float rsc = (rowscale ? rowscale[row0 + ai * HALF + m * 16] : 1.f) * sc;
#pragma unroll
                for (int bj = 0; bj < 2; ++bj) { f32x4 v0 = acc[ai][bj][m][0] * rsc, v1 = acc[ai][bj][m][1] * rsc;
                    if (sq) {
#pragma unroll
                        for (int e = 0; e < 4; ++e) { float a = v0[e] > 0.f ? v0[e] : 0.f; v0[e] = a * a; float b = v1[e] > 0.f ? v1[e] : 0.f; v1[e] = b * b; } }
                    u32x4 w; w.x = cvt_pk_bf16(v0[0], v0[1]); w.y = cvt_pk_bf16(v0[2], v0[3]); w.z = cvt_pk_bf16(v1[0], v1[1]); w.w = cvt_pk_bf16(v1[2], v1[3]);
                    *(u32x4*)(rowp + bj * HALF) = w; } }
    }
};

template <class Epi, class Sched, bool ALIGN_EPI = false, bool SP2 = false>
__device__ __forceinline__ void gemm_phase(PG8_LAS unsigned char* lds, const Gemm g, const Sched& S, const Epi& E) {
    int tid = threadIdx.x; asm volatile("" : "+v"(tid)); const int wid = __builtin_amdgcn_readfirstlane(tid >> 6), lane = tid & 63, wr = wid >> 2, wc = wid & 3, fr = lane & 15, fq = lane >> 4;
    const int K = g.K, nt = K / BK;
    unsigned voffA[2], voffB[2];
#pragma unroll
    for (int i = 0; i < 2; ++i) { int R, C; stage_rc(tid * 16 + i * 8192, R, C); const int Rb = Epi::PERM ? ((R & ~31) + perm32(R & 31)) : R;
        voffA[i] = (unsigned)(R * K + C) * 2u; voffB[i] = (unsigned)(Rb * K + C) * 2u; }
    const size_t kstep = (size_t)(BK * 2);
    const size_t hstep = (size_t)HALF * K * 2;
    const size_t tstep = 2 * hstep;
    const unsigned ldsw = (unsigned)wid * 1024u;
    const int aoff = lds_byte(wr * 64 + fr, fq * 8), boff = lds_byte(wc * 32 + fr, fq * 8);
#define PG8_SA(b, h) (((b) * 2 + (h)) * HTB)
#define PG8_SB(b, h) ((4 + (b) * 2 + (h)) * HTB)
#define PG8_STAGE(bufoff, gbase, voff) do { _Pragma("unroll") for (int _i = 0; _i < 2; ++_i) \
        __builtin_amdgcn_global_load_lds((const unsigned*)((const char*)(gbase) + (voff)[_i]), (PG8_LAS unsigned*)(lds + (bufoff) + ldsw + _i * 8192), 16, 0, 0); } while (0)
#define PG8_LDA(dst, b, h) do { _Pragma("unroll") for (int m = 0; m < 4; ++m) _Pragma("unroll") for (int k = 0; k < 2; ++k) dst[m][k] = *(const PG8_LAS bf16x8*)(lds + PG8_SA(b, h) + aoff + m * 2048 + k * 1024); } while (0)
#define PG8_LDB(dst, b, h) do { _Pragma("unroll") for (int n = 0; n < 2; ++n) _Pragma("unroll") for (int k = 0; k < 2; ++k) dst[n][k] = *(const PG8_LAS bf16x8*)(lds + PG8_SB(b, h) + boff + n * 2048 + k * 1024); } while (0)
#define PG8_MMA(ai, bj, At, Bt) do { __builtin_amdgcn_s_setprio(1); _Pragma("unroll") for (int m = 0; m < 4; ++m) _Pragma("unroll") for (int n = 0; n < 2; ++n) _Pragma("unroll") for (int k = 0; k < 2; ++k) \
        acc[ai][bj][m][n] = __builtin_amdgcn_mfma_f32_16x16x32_bf16(Bt[n][k], At[m][k], acc[ai][bj][m][n], 0, 0, 0); __builtin_amdgcn_s_setprio(0); } while (0)
#define PG8_WAIT_V(n) asm volatile("s_waitcnt vmcnt(" #n ")" ::: "memory")
#define PG8_WAIT_L(n) asm volatile("s_waitcnt lgkmcnt(" #n ")" ::: "memory")
#define PG8_BAR __builtin_amdgcn_s_barrier()
#define PG8_SCHED __builtin_amdgcn_sched_barrier(0)
    Unit cur, nxt; int ui = 0;
    if (!S.next(0, cur)) return;
    f32x4 acc[2][2][4][2];
#pragma unroll
    for (int a = 0; a < 2; ++a)
#pragma unroll
        for (int b = 0; b < 2; ++b)
#pragma unroll
            for (int m = 0; m < 4; ++m)
#pragma unroll
                for (int n = 0; n < 2; ++n) acc[a][b][m][n] = (f32x4){0.f, 0.f, 0.f, 0.f};
    bf16x8 At[4][2], B0[2][2], B1[2][2];
    const char* cA = (const char*)g.A + (size_t)cur.pm * tstep; const char* cB = (const char*)g.Bt + (size_t)cur.pn * tstep;
    S.a_ready(cur);
    if constexpr (SP2) {
        PG8_STAGE(PG8_SB(0, 0), cB, voffB); PG8_STAGE(PG8_SB(0, 1), cB + hstep, voffB); PG8_STAGE(PG8_SA(0, 0), cA, voffA); PG8_STAGE(PG8_SA(0, 1), cA + hstep, voffA);
        if (wr == 1) PG8_BAR;
        PG8_WAIT_V(2); PG8_BAR;
        PG8_STAGE(PG8_SB(1, 0), cB + kstep, voffB); PG8_STAGE(PG8_SA(1, 0), cA + kstep, voffA); PG8_STAGE(PG8_SB(1, 1), cB + hstep + kstep, voffB);
        PG8_WAIT_V(6); PG8_BAR;
    } else {
        PG8_STAGE(PG8_SB(0, 0), cB, voffB); PG8_STAGE(PG8_SA(0, 0), cA, voffA); PG8_STAGE(PG8_SB(0, 1), cB + hstep, voffB); PG8_STAGE(PG8_SA(0, 1), cA + hstep, voffA);
        if (wr == 1) PG8_BAR;
        PG8_WAIT_V(4); PG8_BAR;
        PG8_STAGE(PG8_SB(1, 0), cB + kstep, voffB); PG8_STAGE(PG8_SA(1, 0), cA + kstep, voffA); PG8_STAGE(PG8_SB(1, 1), cB + hstep + kstep, voffB);
        PG8_WAIT_V(6); PG8_BAR;
    }
    for (;;) {
        const bool has_next = S.next(ui + 1, nxt);
        const char* nA = has_next ? (const char*)g.A + (size_t)nxt.pm * tstep : cA; const char* nB = has_next ? (const char*)g.Bt + (size_t)nxt.pn * tstep : cB;
        for (int t = 0; t < nt; t += 2) {
            const bool last = (t == nt - 2);
            const char* a1 = cA + (size_t)(t + 1) * kstep;
            const char* a2 = last ? nA : cA + (size_t)(t + 2) * kstep; const char* b2 = last ? nB : cB + (size_t)(t + 2) * kstep;
            const char* a3 = a2 + kstep; const char* b3 = b2 + kstep;
            if (last && has_next) S.a_ready(nxt);
            if constexpr (SP2) {
            PG8_LDB(B0, 0, 0); PG8_LDB(B1, 0, 1); PG8_SCHED; PG8_LDA(At, 0, 0); PG8_STAGE(PG8_SA(1, 1), a1 + hstep, voffA);
            PG8_WAIT_V(8); PG8_WAIT_L(0); PG8_BAR; PG8_MMA(0, 0, At, B0); PG8_MMA(0, 1, At, B1); PG8_BAR; PG8_SCHED;
            PG8_LDA(At, 0, 1); PG8_STAGE(PG8_SB(0, 0), b2, voffB); PG8_STAGE(PG8_SB(0, 1), b2 + hstep, voffB); PG8_STAGE(PG8_SA(0, 0), a2, voffA);
            PG8_WAIT_V(8); PG8_WAIT_L(0); PG8_BAR; PG8_MMA(1, 0, At, B0); PG8_MMA(1, 1, At, B1); PG8_BAR; PG8_SCHED;
            PG8_LDB(B0, 1, 0); PG8_LDB(B1, 1, 1); PG8_SCHED; PG8_LDA(At, 1, 0); PG8_STAGE(PG8_SA(0, 1), a2 + hstep, voffA);
            PG8_WAIT_V(8); PG8_WAIT_L(0); PG8_BAR; PG8_MMA(0, 0, At, B0); PG8_MMA(0, 1, At, B1); PG8_BAR; PG8_SCHED;
            PG8_LDA(At, 1, 1); PG8_STAGE(PG8_SB(1, 0), b3, voffB); PG8_STAGE(PG8_SB(1, 1), b3 + hstep, voffB); PG8_STAGE(PG8_SA(1, 0), a3, voffA);
            PG8_WAIT_V(8); PG8_WAIT_L(0); PG8_BAR; PG8_MMA(1, 0, At, B0); PG8_MMA(1, 1, At, B1); PG8_BAR; PG8_SCHED;
            } else {
            PG8_LDB(B0, 0, 0); PG8_SCHED; PG8_LDA(At, 0, 0); PG8_STAGE(PG8_SA(1, 1), a1 + hstep, voffA);
            PG8_WAIT_L(8); PG8_BAR; PG8_WAIT_L(0); PG8_MMA(0, 0, At, B0); PG8_BAR; PG8_SCHED;
            PG8_LDB(B1, 0, 1); PG8_STAGE(PG8_SB(0, 0), b2, voffB);
            PG8_BAR; PG8_WAIT_L(0); PG8_MMA(0, 1, At, B1); PG8_BAR;
            PG8_LDA(At, 0, 1); PG8_STAGE(PG8_SA(0, 0), a2, voffA);
            PG8_BAR; PG8_WAIT_L(0); PG8_MMA(1, 0, At, B0); PG8_BAR; PG8_SCHED;
            PG8_STAGE(PG8_SB(0, 1), b2 + hstep, voffB);
            PG8_WAIT_V(6); PG8_BAR; PG8_MMA(1, 1, At, B1); PG8_BAR;
            PG8_LDB(B0, 1, 0); PG8_SCHED; PG8_LDA(At, 1, 0); PG8_STAGE(PG8_SA(0, 1), a2 + hstep, voffA);
            PG8_WAIT_L(8); PG8_BAR; PG8_WAIT_L(0); PG8_MMA(0, 0, At, B0); PG8_BAR; PG8_SCHED;
            PG8_LDB(B1, 1, 1); PG8_STAGE(PG8_SB(1, 0), b3, voffB);
            PG8_BAR; PG8_WAIT_L(0); PG8_MMA(0, 1, At, B1); PG8_BAR;
            PG8_LDA(At, 1, 1); PG8_STAGE(PG8_SA(1, 0), a3, voffA);
            PG8_BAR; PG8_WAIT_L(0); PG8_MMA(1, 0, At, B0); PG8_BAR; PG8_SCHED;
            PG8_STAGE(PG8_SB(1, 1), b3 + hstep, voffB);
            PG8_WAIT_V(6); PG8_BAR; PG8_MMA(1, 1, At, B1); PG8_BAR;
            }
        }
        if constexpr (ALIGN_EPI) { if (wr == 0) PG8_BAR; }
        if constexpr (!Epi::AFTER_DRAIN) { E(acc, cur, wr, wc, fr, fq); S.done(cur); }
        if (!has_next) break;
#pragma unroll
        for (int a = 0; a < 2; ++a)
#pragma unroll
            for (int b = 0; b < 2; ++b)
#pragma unroll
                for (int m = 0; m < 4; ++m)
#pragma unroll
                    for (int n = 0; n < 2; ++n) acc[a][b][m][n] = (f32x4){0.f, 0.f, 0.f, 0.f};
        cur = nxt; cA = nA; cB = nB; ++ui;
        if constexpr (ALIGN_EPI) { if (wr == 1) PG8_BAR; }
    }
    PG8_WAIT_V(0);
    if constexpr (!ALIGN_EPI) { if (wr == 0) PG8_BAR; }
    PG8_BAR;
    if constexpr (Epi::AFTER_DRAIN) { E.fused(acc, cur, wr, wc, fr, fq, lds, wid, lane); S.done(cur); }
#undef PG8_SA
#undef PG8_SB
#undef PG8_STAGE
#undef PG8_LDA
#undef PG8_LDB
#undef PG8_MMA
#undef PG8_WAIT_V
#undef PG8_WAIT_L
#undef PG8_BAR
#undef PG8_SCHED
}
}
#define LAS __attribute__((address_space(3)))
typedef unsigned short bf16;
typedef unsigned v4u __attribute__((ext_vector_type(4)));
typedef unsigned v2u __attribute__((ext_vector_type(2)));
typedef float f32x4 __attribute__((ext_vector_type(4)));
typedef float f32x16 __attribute__((ext_vector_type(16)));
typedef short bf16x8 __attribute__((ext_vector_type(8)));
constexpr int NWAVES = 8, NTHR = 512;
constexpr int BATCH = 8, SEQ = 4096, DM = 2048, MTOK = BATCH * SEQ, DIN = 5120, DFF = 8192, NQKV = 6144;
constexpr float NORM_EPS = 1e-6f;
constexpr size_t MiB = 1u << 20;
constexpr size_t WS_WIN = 0, WS_WOUT = 20 * MiB, WS_WQKV = 28 * MiB, WS_WO = 52 * MiB, WS_WUP0 = 60 * MiB, WS_WUP1 = 92 * MiB, WS_WDN0 = 124 * MiB, WS_WDN1 = 156 * MiB;
constexpr size_t WS_H = 192 * MiB, WS_MIX = 320 * MiB, WS_BIG = 448 * MiB, WS_CTL = 960 * MiB, CTL_BYTES = 16384, WS_RS = 960 * MiB + 65536, WS_END = 961 * MiB;
constexpr int LDS_MISC = 131072, LDS_BYTES = 131072 + 256;

__device__ __forceinline__ float bflo(unsigned u) { return __uint_as_float(u << 16); }
__device__ __forceinline__ float bfhi(unsigned u) { return __uint_as_float(u & 0xffff0000u); }
__device__ __forceinline__ unsigned pk2(float lo, float hi) { return pg8::cvt_pk_bf16(lo, hi); }
__device__ __forceinline__ float wave_sum(float v) {
#pragma unroll
    for (int o = 1; o < 64; o <<= 1) v += __shfl_xor(v, o);
    return v;
}
#define LDS_BARRIER() do { asm volatile("s_waitcnt lgkmcnt(0)" ::: "memory"); __builtin_amdgcn_s_barrier(); asm volatile("" ::: "memory"); } while (0)
__device__ __forceinline__ float fsigmoid(float x) { return __builtin_amdgcn_rcpf(1.f + __expf(-x)); }

__device__ __forceinline__ void p0_transpose_item(const float* W, int K, int N, bf16* WT, LAS float* scr, int item, int lane, const float* gk = nullptr) {
    const int nblk = N / 32, kb = item / nblk, nb = item % nblk, k0 = 64 * kb, n0 = 32 * nb;
    float tv[32];
#pragma unroll
    for (int i = 0; i < 32; ++i) tv[i] = W[(size_t)(k0 + 2 * i + (lane >> 5)) * N + n0 + (lane & 31)];
#pragma unroll
    for (int i = 0; i < 32; ++i) scr[(2 * i + (lane >> 5)) * 33 + (lane & 31)] = tv[i];
    asm volatile("s_waitcnt lgkmcnt(0)" ::: "memory");
    const int c = lane & 7;
    f32x4 g0 = {1.f, 1.f, 1.f, 1.f}, g1 = {1.f, 1.f, 1.f, 1.f};
    if (gk) { g0 = *(const f32x4*)(gk + k0 + 8 * c); g1 = *(const f32x4*)(gk + k0 + 8 * c + 4); }
#pragma unroll
    for (int j = 0; j < 4; ++j) { const int n = (lane >> 3) + 8 * j; const LAS float* s = scr + (8 * c) * 33 + n;
        v4u o; o.x = pk2(s[0 * 33] * g0.x, s[1 * 33] * g0.y); o.y = pk2(s[2 * 33] * g0.z, s[3 * 33] * g0.w); o.z = pk2(s[4 * 33] * g1.x, s[5 * 33] * g1.y); o.w = pk2(s[6 * 33] * g1.z, s[7 * 33] * g1.w);
        *(v4u*)(WT + (size_t)(n0 + n) * K + k0 + 8 * c) = o; }
    asm volatile("s_waitcnt lgkmcnt(0)" ::: "memory");
}

__device__ __forceinline__ void cvt_row(const float* xrow, bf16* orow, float* rs, int lane) {
    f32x4 v[4][2]; float ss = 0.f;
#pragma unroll
    for (int j = 0; j < 4; ++j)
#pragma unroll
        for (int e = 0; e < 2; ++e) { v[j][e] = *(const f32x4*)(xrow + 512 * j + 8 * lane + 4 * e); ss += (v[j][e].x * v[j][e].x + v[j][e].y * v[j][e].y) + (v[j][e].z * v[j][e].z + v[j][e].w * v[j][e].w); }
    const float r = __builtin_amdgcn_rsqf(wave_sum(ss) * (1.f / DM) + NORM_EPS);
#pragma unroll
    for (int j = 0; j < 4; ++j) { const f32x4 a = v[j][0], b = v[j][1];
        v4u o; o.x = pk2(a.x, a.y); o.y = pk2(a.z, a.w); o.z = pk2(b.x, b.y); o.w = pk2(b.z, b.w);
        *(v4u*)(orow + 512 * j + 8 * lane) = o; }
    if (lane == 0) *rs = r;
}

template <bool XIN_F32, bool OUT_F32>
__device__ __forceinline__ void post_row(const bf16* mrow, const float* xin_f, const bf16* xin_b, float* xout_f, bf16* xout_b, const float* gpost, float* rs, int lane) {
    f32x4 mv[4][2], xv[4][2], gp[4][2]; float ss = 0.f;
    v4u r[4], xr[4];
#pragma unroll
    for (int j = 0; j < 4; ++j) r[j] = *(const v4u*)(mrow + 512 * j + 8 * lane);
    if (XIN_F32) {
#pragma unroll
        for (int j = 0; j < 4; ++j)
#pragma unroll
            for (int e = 0; e < 2; ++e) xv[j][e] = *(const f32x4*)(xin_f + 512 * j + 8 * lane + 4 * e);
    } else {
#pragma unroll
        for (int j = 0; j < 4; ++j) xr[j] = *(const v4u*)(xin_b + 512 * j + 8 * lane);
#pragma unroll
        for (int j = 0; j < 4; ++j) { xv[j][0] = (f32x4){bflo(xr[j].x), bfhi(xr[j].x), bflo(xr[j].y), bfhi(xr[j].y)}; xv[j][1] = (f32x4){bflo(xr[j].z), bfhi(xr[j].z), bflo(xr[j].w), bfhi(xr[j].w)}; }
    }
#pragma unroll
    for (int j = 0; j < 4; ++j)
#pragma unroll
        for (int e = 0; e < 2; ++e) gp[j][e] = *(const f32x4*)(gpost + 512 * j + 8 * lane + 4 * e);
#pragma unroll
    for (int j = 0; j < 4; ++j) {
        mv[j][0] = (f32x4){bflo(r[j].x), bfhi(r[j].x), bflo(r[j].y), bfhi(r[j].y)}; mv[j][1] = (f32x4){bflo(r[j].z), bfhi(r[j].z), bflo(r[j].w), bfhi(r[j].w)};
#pragma unroll
        for (int e = 0; e < 2; ++e) ss += (mv[j][e].x * mv[j][e].x + mv[j][e].y * mv[j][e].y) + (mv[j][e].z * mv[j][e].z + mv[j][e].w * mv[j][e].w); }
    const float rs1 = __builtin_amdgcn_rsqf(wave_sum(ss) * (1.f / DM) + NORM_EPS);
    float s2 = 0.f;
#pragma unroll
    for (int j = 0; j < 4; ++j)
#pragma unroll
        for (int e = 0; e < 2; ++e) { const f32x4 x1 = xv[j][e] + mv[j][e] * rs1 * gp[j][e]; mv[j][e] = x1; s2 += (x1.x * x1.x + x1.y * x1.y) + (x1.z * x1.z + x1.w * x1.w); }
    if (OUT_F32) {
#pragma unroll
        for (int j = 0; j < 4; ++j)
#pragma unroll
            for (int e = 0; e < 2; ++e) *(f32x4*)(xout_f + 512 * j + 8 * lane + 4 * e) = mv[j][e];
    } else {
#pragma unroll
        for (int j = 0; j < 4; ++j) { const f32x4 a = mv[j][0], b = mv[j][1];
            v4u o; o.x = pk2(a.x, a.y); o.y = pk2(a.z, a.w); o.z = pk2(b.x, b.y); o.w = pk2(b.z, b.w);
            *(v4u*)(xout_b + 512 * j + 8 * lane) = o; }
        const float rs2 = __builtin_amdgcn_rsqf(wave_sum(s2) * (1.f / DM) + NORM_EPS);
        if (lane == 0) *rs = rs2;
    }
}

template <bool OUT_F32>
__device__ __forceinline__ void post_rows(const bf16* MIXb, bf16* XRb, float* outf, const float* gpost, float* RSb, int gw, int NGW, int lane) {
    f32x4 gp[4][2];
#pragma unroll
    for (int j = 0; j < 4; ++j)
#pragma unroll
        for (int e = 0; e < 2; ++e) gp[j][e] = *(const f32x4*)(gpost + 512 * j + 8 * lane + 4 * e);
    v4u nr[4], nx[4];
#pragma unroll
    for (int j = 0; j < 4; ++j) { nr[j] = *(const v4u*)(MIXb + (size_t)gw * DM + 512 * j + 8 * lane); nx[j] = *(const v4u*)(XRb + (size_t)gw * DM + 512 * j + 8 * lane); }
    for (int m = gw; m < MTOK; m += NGW) {
        v4u r[4], xr[4];
#pragma unroll
        for (int j = 0; j < 4; ++j) { r[j] = nr[j]; xr[j] = nx[j]; }
        const int mn = m + NGW;
        if (mn < MTOK) {
#pragma unroll
            for (int j = 0; j < 4; ++j) { nr[j] = *(const v4u*)(MIXb + (size_t)mn * DM + 512 * j + 8 * lane); nx[j] = *(const v4u*)(XRb + (size_t)mn * DM + 512 * j + 8 * lane); } }
        f32x4 mv[4][2]; float ss = 0.f;
#pragma unroll
        for (int j = 0; j < 4; ++j) {
            mv[j][0] = (f32x4){bflo(r[j].x), bfhi(r[j].x), bflo(r[j].y), bfhi(r[j].y)}; mv[j][1] = (f32x4){bflo(r[j].z), bfhi(r[j].z), bflo(r[j].w), bfhi(r[j].w)};
#pragma unroll
            for (int e = 0; e < 2; ++e) ss += (mv[j][e].x * mv[j][e].x + mv[j][e].y * mv[j][e].y) + (mv[j][e].z * mv[j][e].z + mv[j][e].w * mv[j][e].w); }
        const float rs1 = __builtin_amdgcn_rsqf(wave_sum(ss) * (1.f / DM) + NORM_EPS);
        float s2 = 0.f;
#pragma unroll
        for (int j = 0; j < 4; ++j) {
            const f32x4 x0 = (f32x4){bflo(xr[j].x), bfhi(xr[j].x), bflo(xr[j].y), bfhi(xr[j].y)}, x1 = (f32x4){bflo(xr[j].z), bfhi(xr[j].z), bflo(xr[j].w), bfhi(xr[j].w)};
            const f32x4 a = x0 + mv[j][0] * rs1 * gp[j][0], b = x1 + mv[j][1] * rs1 * gp[j][1]; mv[j][0] = a; mv[j][1] = b;
            s2 += ((a.x * a.x + a.y * a.y) + (a.z * a.z + a.w * a.w)) + ((b.x * b.x + b.y * b.y) + (b.z * b.z + b.w * b.w)); }
        if (OUT_F32) {
#pragma unroll
            for (int j = 0; j < 4; ++j)
#pragma unroll
                for (int e = 0; e < 2; ++e) *(f32x4*)(outf + (size_t)m * DM + 512 * j + 8 * lane + 4 * e) = mv[j][e];
        } else {
#pragma unroll
            for (int j = 0; j < 4; ++j) { const f32x4 a = mv[j][0], b = mv[j][1];
                v4u o; o.x = pk2(a.x, a.y); o.y = pk2(a.z, a.w); o.z = pk2(b.x, b.y); o.w = pk2(b.z, b.w);
                *(v4u*)(XRb + (size_t)m * DM + 512 * j + 8 * lane) = o; }
            const float rs2 = __builtin_amdgcn_rsqf(wave_sum(s2) * (1.f / DM) + NORM_EPS);
            if (lane == 0) RSb[m] = rs2;
        }
    }
}

__device__ __forceinline__ void cvt_rows(const float* x, bf16* XRb, float* RSb, int gw, int NGW, int lane) {
    f32x4 nv[4][2];
#pragma unroll
    for (int j = 0; j < 4; ++j)
#pragma unroll
        for (int e = 0; e < 2; ++e) nv[j][e] = *(const f32x4*)(x + (size_t)gw * DM + 512 * j + 8 * lane + 4 * e);
    for (int m = gw; m < MTOK; m += NGW) {
        f32x4 v[4][2]; float ss = 0.f;
#pragma unroll
        for (int j = 0; j < 4; ++j)
#pragma unroll
            for (int e = 0; e < 2; ++e) v[j][e] = nv[j][e];
        const int mn = m + NGW;
        if (mn < MTOK) {
#pragma unroll
            for (int j = 0; j < 4; ++j)
#pragma unroll
                for (int e = 0; e < 2; ++e) nv[j][e] = *(const f32x4*)(x + (size_t)mn * DM + 512 * j + 8 * lane + 4 * e); }
#pragma unroll
        for (int j = 0; j < 4; ++j)
#pragma unroll
            for (int e = 0; e < 2; ++e) ss += (v[j][e].x * v[j][e].x + v[j][e].y * v[j][e].y) + (v[j][e].z * v[j][e].z + v[j][e].w * v[j][e].w);
        const float r = __builtin_amdgcn_rsqf(wave_sum(ss) * (1.f / DM) + NORM_EPS);
#pragma unroll
        for (int j = 0; j < 4; ++j) { const f32x4 a = v[j][0], b = v[j][1];
            v4u o; o.x = pk2(a.x, a.y); o.y = pk2(a.z, a.w); o.z = pk2(b.x, b.y); o.w = pk2(b.z, b.w);
            *(v4u*)(XRb + (size_t)m * DM + 512 * j + 8 * lane) = o; }
        if (lane == 0) RSb[m] = r;
    }
}

__device__ __forceinline__ void mixerA_item(const bf16* proj, const float* conv_a, bf16* Y, int item, int tid) {
    const int cgp = tid & 127, tg = tid >> 7, c0 = 8 * cgp;
    const int row0 = item * 64 + tg * 16, t0 = row0 & (SEQ - 1);
    float w0[8], w1[8], w2[8], u1[8], u2[8];
#pragma unroll
    for (int e = 0; e < 8; ++e) { w0[e] = conv_a[c0 + e]; w1[e] = conv_a[1024 + c0 + e]; w2[e] = conv_a[2048 + c0 + e]; u1[e] = 0.f; u2[e] = 0.f; }
    if (t0 != 0) {
        const v4u c2 = *(const v4u*)(proj + (size_t)(row0 - 2) * DIN + 1024 + c0), x2 = *(const v4u*)(proj + (size_t)(row0 - 2) * DIN + 2048 + c0);
        const v4u c1 = *(const v4u*)(proj + (size_t)(row0 - 1) * DIN + 1024 + c0), x1 = *(const v4u*)(proj + (size_t)(row0 - 1) * DIN + 2048 + c0);
#pragma unroll
        for (int q = 0; q < 4; ++q) { u2[2 * q] = bflo(c2[q]) * bflo(x2[q]); u2[2 * q + 1] = bfhi(c2[q]) * bfhi(x2[q]); u1[2 * q] = bflo(c1[q]) * bflo(x1[q]); u1[2 * q + 1] = bfhi(c1[q]) * bfhi(x1[q]); }
    }
    for (int i0 = 0; i0 < 16; i0 += 4) {
        v4u bg[4], cgv[4], ax[4];
#pragma unroll
        for (int i = 0; i < 4; ++i) { const bf16* p = proj + (size_t)(row0 + i0 + i) * DIN + c0; bg[i] = *(const v4u*)p; cgv[i] = *(const v4u*)(p + 1024); ax[i] = *(const v4u*)(p + 2048); }
#pragma unroll
        for (int i = 0; i < 4; ++i) {
            float u0[8], y[8];
#pragma unroll
            for (int q = 0; q < 4; ++q) { u0[2 * q] = bflo(cgv[i][q]) * bflo(ax[i][q]); u0[2 * q + 1] = bfhi(cgv[i][q]) * bfhi(ax[i][q]); }
#pragma unroll
            for (int q = 0; q < 4; ++q) { y[2 * q] = bflo(bg[i][q]) * (w0[2 * q] * u2[2 * q] + w1[2 * q] * u1[2 * q] + w2[2 * q] * u0[2 * q]);
                y[2 * q + 1] = bfhi(bg[i][q]) * (w0[2 * q + 1] * u2[2 * q + 1] + w1[2 * q + 1] * u1[2 * q + 1] + w2[2 * q + 1] * u0[2 * q + 1]); }
            v4u o; o.x = pk2(y[0], y[1]); o.y = pk2(y[2], y[3]); o.z = pk2(y[4], y[5]); o.w = pk2(y[6], y[7]);
            *(v4u*)(Y + (size_t)(row0 + i0 + i) * DM + c0) = o;
#pragma unroll
            for (int e = 0; e < 8; ++e) { u2[e] = u1[e]; u1[e] = u0[e]; }
        }
    }
}

template <int SHR> __device__ __forceinline__ float dpp_shr(float oldv, float src) {
    return __builtin_bit_cast(float, __builtin_amdgcn_update_dpp(__builtin_bit_cast(int, oldv), __builtin_bit_cast(int, src), 0x110 + SHR, 0xf, 0xf, false));
}
template <int SHR> __device__ __forceinline__ void scan_step(float (&av)[16], float (&bv)[16]) {
#pragma unroll
    for (int i = 0; i < 16; ++i) { const float ap = dpp_shr<SHR>(1.f, av[i]); const float bp = dpp_shr<SHR>(0.f, bv[i]); bv[i] = av[i] * bp + bv[i]; av[i] = av[i] * ap; }
}
__device__ __forceinline__ void mixerB_item(const bf16* proj, const float* conv_b, const float* conv_b_bias, const float* w_a, const float* b_a, const float* w_x, const float* b_x,
                                            const float* lam, bf16* Y, int item, LAS unsigned char* lds, int tid) {
    const int b = item >> 4, hd = item & 15;
    const int lane = tid & 63, w = __builtin_amdgcn_readfirstlane(tid >> 6), fr = lane & 15, fq = lane >> 4;
    LAS float* cst = (LAS float*)lds;
    LAS float* agg = cst + 512;
    __syncthreads();
    { const int k = tid >> 6, c = tid & 63, ch = hd * 64 + c; float v;
      if (k < 4) v = conv_b[k * 1024 + ch]; else if (k == 4) v = conv_b_bias[ch]; else if (k == 5) v = b_a[ch]; else if (k == 6) v = b_x[ch];
      else { const float l = lam[ch]; v = 8.f * (fminf(l, 0.f) - log1pf(__expf(-fabsf(l)))); }
      cst[k * 64 + c] = v; }
    LAS unsigned char* wf = lds + 10240;
    {
#pragma unroll
        for (int q = 0; q < 2; ++q) { const int fi = w * 2 + q, mat = fi >> 3, mt = (fi >> 1) & 3, s = fi & 1; const float* wsrc = mat ? w_x : w_a; bf16x8 fragv;
#pragma unroll
            for (int jj = 0; jj < 8; ++jj) { const int idx = 8 * s + jj; const int i = 16 * (idx >> 2) + 4 * fq + (idx & 3); const int j = 16 * mt + fr;
                fragv[jj] = (short)pg8::f2bf1(wsrc[(size_t)(hd * 64 + i) * 64 + j]); }
            *(LAS bf16x8*)(wf + fi * 1024 + lane * 16) = fragv; }
    }
    __syncthreads();
    float hc[16];
#pragma unroll
    for (int i = 0; i < 16; ++i) hc[i] = 0.f;
    const bf16* pbx = proj + (size_t)(b * SEQ) * DIN + 4096 + hd * 64 + 4 * fq;
    const bf16* pgt = proj + (size_t)(b * SEQ) * DIN + 3072 + hd * 64 + 4 * fq;
    bf16* py = Y + (size_t)(b * SEQ) * DM + 1024 + hd * 64 + 4 * fq;
    v2u nraw[4][4], ngraw[4];
#define MB_LOAD(cc) do { const int t_ = (cc) * 128 + w * 16 + fr; _Pragma("unroll") for (int k = 0; k < 4; ++k) { const int tok = t_ - 3 + k; \
        _Pragma("unroll") for (int g = 0; g < 4; ++g) { nraw[k][g] = (v2u){0u, 0u}; if (tok >= 0) nraw[k][g] = *(const v2u*)(pbx + (size_t)tok * DIN + 16 * g); } } \
        _Pragma("unroll") for (int g = 0; g < 4; ++g) ngraw[g] = *(const v2u*)(pgt + (size_t)t_ * DIN + 16 * g); } while (0)
    MB_LOAD(0);
    for (int c = 0; c < SEQ / 128; ++c) {
        asm volatile("" ::: "memory");
        const int t = c * 128 + w * 16 + fr;
        v2u raw[4][4], graw[4];
#pragma unroll
        for (int k = 0; k < 4; ++k)
#pragma unroll
            for (int g = 0; g < 4; ++g) raw[k][g] = nraw[k][g];
#pragma unroll
        for (int g = 0; g < 4; ++g) graw[g] = ngraw[g];
        if (c + 1 < SEQ / 128) MB_LOAD(c + 1);
        float xr[16];
#pragma unroll
        for (int g = 0; g < 4; ++g) { f32x4 acc = *(const LAS f32x4*)(cst + 4 * 64 + 16 * g + 4 * fq);
#pragma unroll
            for (int k = 0; k < 4; ++k) { const f32x4 wk = *(const LAS f32x4*)(cst + k * 64 + 16 * g + 4 * fq);
                acc.x += wk.x * bflo(raw[k][g].x); acc.y += wk.y * bfhi(raw[k][g].x); acc.z += wk.z * bflo(raw[k][g].y); acc.w += wk.w * bfhi(raw[k][g].y); }
            xr[4 * g] = acc.x; xr[4 * g + 1] = acc.y; xr[4 * g + 2] = acc.z; xr[4 * g + 3] = acc.w; }
        bf16x8 xb[2];
#pragma unroll
        for (int s = 0; s < 2; ++s) { const unsigned p0 = pk2(xr[8 * s], xr[8 * s + 1]), p1 = pk2(xr[8 * s + 2], xr[8 * s + 3]), p2 = pk2(xr[8 * s + 4], xr[8 * s + 5]), p3 = pk2(xr[8 * s + 6], xr[8 * s + 7]);
            xb[s] = __builtin_bit_cast(bf16x8, (v4u){p0, p1, p2, p3}); }
        float av[16], bv[16];
#pragma unroll
        for (int mt = 0; mt < 4; ++mt) { f32x4 ga = {0.f, 0.f, 0.f, 0.f}, gx = {0.f, 0.f, 0.f, 0.f};
            asm volatile("" : "+v"(ga), "+v"(gx));
#pragma unroll
            for (int s = 0; s < 2; ++s) { const bf16x8 wa_ = *(const LAS bf16x8*)(wf + (mt * 2 + s) * 1024 + lane * 16), wx_ = *(const LAS bf16x8*)(wf + (8 + mt * 2 + s) * 1024 + lane * 16);
                ga = __builtin_amdgcn_mfma_f32_16x16x32_bf16(wa_, xb[s], ga, 0, 0, 0); gx = __builtin_amdgcn_mfma_f32_16x16x32_bf16(wx_, xb[s], gx, 0, 0, 0); }
            const f32x4 ba4 = *(const LAS f32x4*)(cst + 5 * 64 + 16 * mt + 4 * fq), bx4 = *(const LAS f32x4*)(cst + 6 * 64 + 16 * mt + 4 * fq), cl4 = *(const LAS f32x4*)(cst + 7 * 64 + 16 * mt + 4 * fq);
#pragma unroll
            for (int r = 0; r < 4; ++r) { const float ra = fsigmoid(ga[r] + ba4[r]), ia = fsigmoid(gx[r] + bx4[r]); const float la = cl4[r] * ra;
                const float a = __expf(la); const float m2 = fmaxf(1.f - __expf(2.f * la), 0.f);
                av[4 * mt + r] = a; bv[4 * mt + r] = __builtin_amdgcn_sqrtf(m2) * ia * xr[4 * mt + r]; } }
        scan_step<1>(av, bv); scan_step<2>(av, bv); scan_step<4>(av, bv); scan_step<8>(av, bv);
        LAS float* ag = agg + (c & 1) * 1024;
        if (fr == 15) {
#pragma unroll
            for (int g = 0; g < 4; ++g) { LAS float* p = ag + (w * 64 + 16 * g + 4 * fq) * 2;
                *(LAS f32x4*)p = (f32x4){av[4 * g], bv[4 * g], av[4 * g + 1], bv[4 * g + 1]}; *(LAS f32x4*)(p + 4) = (f32x4){av[4 * g + 2], bv[4 * g + 2], av[4 * g + 3], bv[4 * g + 3]}; }
        }
        LDS_BARRIER();
        float hin[16];
#pragma unroll
        for (int i = 0; i < 16; ++i) hin[i] = 0.f;
#pragma unroll
        for (int w2 = 0; w2 < 8; ++w2) {
            if (w2 == w) {
#pragma unroll
                for (int i = 0; i < 16; ++i) hin[i] = hc[i]; }
#pragma unroll
            for (int g = 0; g < 4; ++g) { const LAS float* p = ag + (w2 * 64 + 16 * g + 4 * fq) * 2; const f32x4 q0 = *(const LAS f32x4*)p, q1 = *(const LAS f32x4*)(p + 4);
                hc[4 * g] = q0.x * hc[4 * g] + q0.y; hc[4 * g + 1] = q0.z * hc[4 * g + 1] + q0.w; hc[4 * g + 2] = q1.x * hc[4 * g + 2] + q1.y; hc[4 * g + 3] = q1.z * hc[4 * g + 3] + q1.w; }
        }
#pragma unroll
        for (int g = 0; g < 4; ++g) { float y[4];
#pragma unroll
            for (int r = 0; r < 4; ++r) { const int i = 4 * g + r; const float hv = bv[i] + av[i] * hin[i];
                const float gt = (r & 1) ? bfhi(r < 2 ? graw[g].x : graw[g].y) : bflo(r < 2 ? graw[g].x : graw[g].y);
                const float inner = 1.5957691216057308f * (gt + 0.044715f * gt * gt * gt);
                y[r] = hv * gt * fsigmoid(inner); }
            *(v2u*)(py + (size_t)t * DM + 16 * g) = (v2u){pk2(y[0], y[1]), pk2(y[2], y[3])}; }
    }
}

__device__ __forceinline__ int crow(int i, int hh) { return (i & 3) + 8 * (i >> 2) + 4 * hh; }
constexpr int AK_PITCH = 272, AV_PITCH = 80, AK_BYTES = 32 * AK_PITCH, AV_BYTES = 128 * AV_PITCH, A_FLAGS = 4 * AK_BYTES + 4 * AV_BYTES;
constexpr float SB_DONE = -160.f;
__device__ __forceinline__ void att_compute(LAS unsigned char* lds, int cur, int hsel, int qi, int hh, int tq, int kt, bool diag, const bf16x8 (&qf)[8], f32x16 (&o)[4], float& carry) {
    const LAS unsigned char* kb_ = lds + (cur * 2 + hsel) * AK_BYTES; const LAS unsigned char* vb_ = lds + 4 * AK_BYTES + (cur * 2 + hsel) * AV_BYTES;
    const int key0 = 32 * kt;
    f32x16 s;
#pragma unroll
    for (int i = 0; i < 16; ++i) s[i] = 0.f;
    asm volatile("" : "+v"(s));
#pragma unroll
    for (int ks = 0; ks < 8; ++ks) { const bf16x8 kf = *(const LAS bf16x8*)(kb_ + qi * AK_PITCH + 32 * ks + 16 * hh);
        s = __builtin_amdgcn_mfma_f32_32x32x16_bf16(kf, qf[ks], s, 0, 0, 0); }
    float ln[16], lw[16];
#pragma unroll
    for (int i = 0; i < 16; ++i) { const float z = s[i]; const float tt = __builtin_amdgcn_exp2f(-fabsf(z)); const float L = fmaxf(z, 0.f) + __builtin_amdgcn_logf(1.f + tt);
        const bool valid = !diag || (key0 + crow(i, hh) < tq);
        ln[i] = valid ? -L : 0.f; lw[i] = valid ? (z - L) : -1e30f; }
    float so[4], sp[4], tot[4];
#pragma unroll
    for (int g = 0; g < 4; ++g) { so[g] = (ln[4 * g] + ln[4 * g + 1]) + (ln[4 * g + 2] + ln[4 * g + 3]); sp[g] = __shfl_xor(so[g], 32); tot[g] = so[g] + sp[g]; }
    float after[4];
    after[3] = (hh == 0) ? sp[3] : 0.f;
    after[2] = tot[3] + ((hh == 0) ? sp[2] : 0.f);
    after[1] = tot[3] + tot[2] + ((hh == 0) ? sp[1] : 0.f);
    after[0] = tot[3] + tot[2] + tot[1] + ((hh == 0) ? sp[0] : 0.f);
    float wv[16];
#pragma unroll
    for (int g = 0; g < 4; ++g) { const float x3 = carry + after[g], x2 = x3 + ln[4 * g + 3], x1 = x2 + ln[4 * g + 2], x0 = x1 + ln[4 * g + 1];
        wv[4 * g + 3] = __builtin_amdgcn_exp2f(lw[4 * g + 3] + x3); wv[4 * g + 2] = __builtin_amdgcn_exp2f(lw[4 * g + 2] + x2);
        wv[4 * g + 1] = __builtin_amdgcn_exp2f(lw[4 * g + 1] + x1); wv[4 * g] = __builtin_amdgcn_exp2f(lw[4 * g] + x0); }
    carry += (tot[0] + tot[1]) + (tot[2] + tot[3]);
    const bf16x8 pa0 = __builtin_bit_cast(bf16x8, (v4u){pk2(wv[0], wv[1]), pk2(wv[2], wv[3]), pk2(wv[4], wv[5]), pk2(wv[6], wv[7])});
    const bf16x8 pa1 = __builtin_bit_cast(bf16x8, (v4u){pk2(wv[8], wv[9]), pk2(wv[10], wv[11]), pk2(wv[12], wv[13]), pk2(wv[14], wv[15])});
#pragma unroll
    for (int dt = 0; dt < 4; ++dt) { const LAS unsigned char* vp = vb_ + (32 * dt + qi) * AV_PITCH + 16 * hh;
        const bf16x8 v0 = *(const LAS bf16x8*)vp, v1 = *(const LAS bf16x8*)(vp + 32);
        o[dt] = __builtin_amdgcn_mfma_f32_32x32x16_bf16(v0, pa0, o[dt], 0, 0, 0); o[dt] = __builtin_amdgcn_mfma_f32_32x32x16_bf16(v1, pa1, o[dt], 0, 0, 0); }
}
__device__ __forceinline__ void attn_unit(const bf16* Q, const bf16* K, const bf16* Vt, bf16* Y, int unit, LAS unsigned char* lds, int tid) {
    const int qb = unit & 31, hp = (unit >> 5) & 7, b = unit >> 8;
    const int lane = tid & 63, w = __builtin_amdgcn_readfirstlane(tid >> 6), qi = lane & 31, hh = lane >> 5;
    const int hsel = w >> 2, wl = w & 3, h = 2 * hp + hsel;
    const int q0 = qb * 128, tq = q0 + 32 * wl + qi;
    LAS int* flags = (LAS int*)(lds + A_FLAGS);
    __syncthreads();
    if (tid < 16) flags[tid] = 0;
    bf16x8 qf[8];
    { const bf16* qp = Q + (size_t)(b * SEQ + tq) * DM + h * 128 + 8 * hh;
#pragma unroll
      for (int ks = 0; ks < 8; ++ks) qf[ks] = *(const bf16x8*)(qp + 16 * ks); }
    f32x16 o[4];
#pragma unroll
    for (int dt = 0; dt < 4; ++dt)
#pragma unroll
        for (int i = 0; i < 16; ++i) o[dt][i] = 0.f;
#pragma unroll
    for (int dt = 0; dt < 4; ++dt) asm volatile("" : "+v"(o[dt]));
    float carry = 0.f; bool done = false;
    const int ktop = 4 * qb + 3, ktw = 4 * qb + wl;
    const int kkey = tid >> 4, kc = tid & 15;
    const int vd = tid >> 2, vc4 = tid & 3;
    const bf16* kg = K + (size_t)(b * SEQ + kkey) * DM + (2 * hp) * 128 + 8 * kc;
    const bf16* vg = Vt + ((size_t)((b * 16 + 2 * hp) * 128 + vd) << 12) + 8 * vc4;
    const int kdst = kkey * AK_PITCH + 16 * kc;
    const int vdst = vd * AV_PITCH + 2 * (16 * (vc4 >> 1) + 4 * (vc4 & 1));
    v4u kr[2], vr[2];
#define A_LOAD(kt) do { _Pragma("unroll") for (int i_ = 0; i_ < 2; ++i_) { kr[i_] = *(const v4u*)(kg + i_ * 128 + (size_t)(32 * (kt)) * DM); vr[i_] = *(const v4u*)(vg + ((size_t)(128 * i_) << 12) + 32 * (kt)); } } while (0)
#define A_WRITE(bufi) do { _Pragma("unroll") for (int i_ = 0; i_ < 2; ++i_) { *(LAS v4u*)(lds + ((bufi) * 2 + i_) * AK_BYTES + kdst) = kr[i_]; \
        LAS unsigned char* vp_ = lds + 4 * AK_BYTES + ((bufi) * 2 + i_) * AV_BYTES + vdst; *(LAS v2u*)vp_ = (v2u){vr[i_].x, vr[i_].y}; *(LAS v2u*)(vp_ + 16) = (v2u){vr[i_].z, vr[i_].w}; } } while (0)
    A_LOAD(ktop); A_WRITE(0);
    if (ktop > 0) A_LOAD(ktop - 1);
    v4u kr2[2], vr2[2];
#pragma unroll
    for (int i_ = 0; i_ < 2; ++i_) { kr2[i_] = kr[i_]; vr2[i_] = vr[i_]; }
    int it = 0, kt = ktop; bool fin = false;
#define ATT_STEP(KW, VW, KL, VL) do { \
        const int cur = it & 1; \
        if (kt > 1) { _Pragma("unroll") for (int i_ = 0; i_ < 2; ++i_) { KL[i_] = *(const v4u*)(kg + i_ * 128 + (size_t)(32 * (kt - 2)) * DM); VL[i_] = *(const v4u*)(vg + ((size_t)(128 * i_) << 12) + 32 * (kt - 2)); } } \
        LDS_BARRIER(); \
        if (it > 0) { const LAS int* f = flags + ((it - 1) & 1) * 8; int all = 1; _Pragma("unroll") for (int i = 0; i < 8; ++i) all &= f[i]; if (all) { fin = true; break; } } \
        if (!done && kt <= ktw) { att_compute(lds, cur, hsel, qi, hh, tq, kt, kt == ktw, qf, o, carry); done = (__builtin_amdgcn_ballot_w64(carry > SB_DONE) == 0ull); } \
        if (lane == 0) flags[cur * 8 + w] = done ? 1 : 0; \
        if (kt == 0) { fin = true; break; } \
        _Pragma("unroll") for (int i_ = 0; i_ < 2; ++i_) { *(LAS v4u*)(lds + ((cur ^ 1) * 2 + i_) * AK_BYTES + kdst) = KW[i_]; \
            LAS unsigned char* vp_ = lds + 4 * AK_BYTES + ((cur ^ 1) * 2 + i_) * AV_BYTES + vdst; *(LAS v2u*)vp_ = (v2u){VW[i_].x, VW[i_].y}; *(LAS v2u*)(vp_ + 16) = (v2u){VW[i_].z, VW[i_].w}; } \
        ++it; --kt; } while (0)
    while (!fin) { ATT_STEP(kr, vr, kr2, vr2); if (fin) break; ATT_STEP(kr2, vr2, kr, vr); }
#undef ATT_STEP
#undef A_LOAD
#undef A_WRITE
    bf16* yp = Y + (size_t)(b * SEQ + tq) * DM + h * 128 + 4 * hh;
#pragma unroll
    for (int dt = 0; dt < 4; ++dt)
#pragma unroll
        for (int g = 0; g < 4; ++g) *(v2u*)(yp + 32 * dt + 8 * g) = (v2u){pk2(o[dt][4 * g], o[dt][4 * g + 1]), pk2(o[dt][4 * g + 2], o[dt][4 * g + 3])};
}

#define XB_TMO      128
#define XB_XCNT(j)  (256  + 64 * (j))
#define XB_XSUB(j)  (1280 + 64 * (j))
#define XB_XGEN(j)  (2304 + 64 * (j))
#define XB_TOP      3328
#define XB_TOPGEN   3392
#define XCD_BAR_WORDS 3456
#define XB_SPIN_CAP (1u << 18)

__device__ __forceinline__ unsigned xb_ld(unsigned* p)              { return __hip_atomic_load(p, __ATOMIC_RELAXED, __HIP_MEMORY_SCOPE_AGENT); }
__device__ __forceinline__ unsigned xb_add(unsigned* p, unsigned v) { return __hip_atomic_fetch_add(p, v, __ATOMIC_RELAXED, __HIP_MEMORY_SCOPE_AGENT); }
__device__ __forceinline__ unsigned xb_xcc_id() { return (unsigned)__builtin_amdgcn_s_getreg((3 << 11) | 20) & 0xFu; }
#define XB_SPIN(cond, bar) do { unsigned _sp = 0; while (cond) { __builtin_amdgcn_s_sleep(1); \
    if ((++_sp & 255u) == 0u) { if (xb_ld(&(bar)[XB_TMO])) break; if (_sp > XB_SPIN_CAP) { atomicAdd(&(bar)[XB_TMO], 1u); break; } } } } while (0)

struct XcdBarrier {
    unsigned* bar; unsigned x;
    volatile LAS unsigned* st;
};

__device__ __forceinline__ XcdBarrier xcd_barrier_post(unsigned* bar, volatile LAS unsigned* st) {
    XcdBarrier b; b.bar = bar; b.x = xb_xcc_id(); b.st = st;
    if (threadIdx.x == 0) (void)xb_add(&bar[XB_XCNT(b.x)], 1u);
    return b;
}
__device__ __forceinline__ void xcd_barrier_complete(unsigned* bar, unsigned x, unsigned& nloc, unsigned& nx) {
    const unsigned G = gridDim.x * gridDim.y * gridDim.z;
    unsigned sum, cnt, mine, sp = 0u;
    for (;;) {
        sum = 0u; cnt = 0u; mine = 0u;
#pragma unroll
        for (unsigned j = 0; j < 16; ++j) { const unsigned c = xb_ld(&bar[XB_XCNT(j)]); sum += c; cnt += (c > 0u) ? 1u : 0u; mine = (j == x) ? c : mine; }
        if (sum == G) break;
        __builtin_amdgcn_s_sleep(1);
        if ((++sp & 255u) == 0u) { if (xb_ld(&bar[XB_TMO])) break; if (sp > XB_SPIN_CAP) { atomicAdd(&bar[XB_TMO], 1u); break; } }
    }
    nloc = mine > 0u ? mine : 1u; nx = cnt > 0u ? cnt : 1u;
}

__device__ __forceinline__ void xcd_barrier(const XcdBarrier& b) {
    asm volatile("s_waitcnt vmcnt(0)" ::: "memory");
    __syncthreads();
    if (threadIdx.x == 0) {
        unsigned* bar = b.bar;
        __builtin_amdgcn_s_waitcnt(0);
        unsigned nloc = b.st[0], nx = b.st[1];
        if (nloc == 0u) { xcd_barrier_complete(bar, b.x, nloc, nx); b.st[0] = nloc; b.st[1] = nx; }
        const unsigned old = xb_add(&bar[XB_XSUB(b.x)], 1u);
        const unsigned gen = old / nloc;
        if (old + 1u == (gen + 1u) * nloc) {
            __builtin_amdgcn_fence(__ATOMIC_RELEASE, "agent");
            asm volatile("s_waitcnt vmcnt(0)" ::: "memory");
            const unsigned og = xb_add(&bar[XB_TOP], 1u);
            const unsigned tg = og / nx;
            if (og + 1u == (tg + 1u) * nx) xb_add(&bar[XB_TOPGEN], 1u);
            else XB_SPIN(xb_ld(&bar[XB_TOPGEN]) == tg, bar);
            __builtin_amdgcn_fence(__ATOMIC_ACQUIRE, "agent");
            xb_add(&bar[XB_XGEN(b.x)], 1u);
            asm volatile("s_waitcnt vmcnt(0)" ::: "memory");
        } else {
            XB_SPIN(xb_ld(&bar[XB_XGEN(b.x)]) == gen, bar);
            __builtin_amdgcn_fence(__ATOMIC_ACQUIRE, "agent");
            asm volatile("s_waitcnt vmcnt(0)" ::: "memory");
        }
    }
    __syncthreads();
}

struct Args { const float* in[16]; float* out; unsigned char* ws; };
__global__ void __launch_bounds__(NTHR, 2) mega_fwd(Args args) {
    extern __shared__ __attribute__((aligned(16))) unsigned char lds_raw[];
    LAS unsigned char* lds = (LAS unsigned char*)lds_raw;
    cg::grid_group grid = cg::this_grid();
    if (threadIdx.x < 64) ((LAS unsigned*)(lds + LDS_MISC))[threadIdx.x] = 0u;
    __syncthreads();
    const XcdBarrier bar = xcd_barrier_post((unsigned*)(args.ws + WS_CTL), (volatile LAS unsigned*)(lds + LDS_MISC) + 8);
    const int G = gridDim.x, bx = blockIdx.x, NGW = G * NWAVES;
    unsigned char* ws = args.ws;
    const float* x = args.in[0]; const float* gains = args.in[1];
    bf16* Wt_in = (bf16*)(ws + WS_WIN); bf16* Wt_out = (bf16*)(ws + WS_WOUT); bf16* Wt_qkv = (bf16*)(ws + WS_WQKV); bf16* Wt_o = (bf16*)(ws + WS_WO);
    bf16* XR = (bf16*)(ws + WS_H); bf16* MIX = (bf16*)(ws + WS_MIX); bf16* BIG = (bf16*)(ws + WS_BIG); float* RS = (float*)(ws + WS_RS);
    float* out = args.out; bf16* Yb = (bf16*)args.out;

    bf16* Qb = BIG; bf16* Kb = BIG + (size_t)MTOK * DM; bf16* Vtb = BIG + 2 * (size_t)MTOK * DM;
    for (int ph = 0; ph < 15; ++ph) {
        int tid = threadIdx.x; asm volatile("" : "+v"(tid));
        const int lane = tid & 63, wave = __builtin_amdgcn_readfirstlane(tid >> 6), gw = bx * NWAVES + wave;
        const int layer = ph >= 8 ? 1 : 0;
        const float* g = gains + (size_t)layer * 4 * DM;
        int gk = -1;
        if (ph == 1 || ph == 3 || ph == 5 || ph == 6 || ph == 8 || ph == 10 || ph == 12 || ph == 13) gk = ph;
        if (gk >= 0) {
#ifndef NO_GEMM
            pg8::Gemm gm{XR, Wt_in, MTOK, DIN, DM}; pg8::EpiGen E{0, BIG, DIN, Kb, Vtb, 0.08838834764831845f * 1.4426950408889634f, RS};
            if (gk == 3) { gm.A = Yb; gm.Bt = Wt_out; gm.N = DM; E.O = MIX; E.ldc = DM; E.rowscale = nullptr; }
            else if (gk == 5 || gk == 12) { gm.Bt = (const bf16*)(ws + (gk == 12 ? WS_WUP1 : WS_WUP0)); gm.N = DFF; E.mode = 2; E.ldc = DFF; }
            else if (gk == 6 || gk == 13) { gm.A = BIG; gm.Bt = (const bf16*)(ws + (gk == 13 ? WS_WDN1 : WS_WDN0)); gm.N = DM; gm.K = DFF; E.O = MIX; E.ldc = DM; E.rowscale = nullptr; }
            else if (gk == 8) { gm.Bt = Wt_qkv; gm.N = NQKV; E.mode = 3; E.O = Qb; E.ldc = DM; }
            else if (gk == 10) { gm.A = Yb; gm.Bt = Wt_o; gm.N = DM; E.O = MIX; E.ldc = DM; E.rowscale = nullptr; }
            pg8::StaticOrder S; S.init(MTOK, gm.N, G, bx);
            pg8::gemm_phase<pg8::EpiGen, pg8::StaticOrder, true, true>(lds, gm, S, E);
#endif
        } else if (ph == 0) {
#ifndef NO_P0
            LAS float* scr = (LAS float*)(lds + wave * 16384);
            constexpr int I_IN = 32 * 160;
            for (int it = gw; it < I_IN; it += NGW) p0_transpose_item(args.in[2], DM, DIN, Wt_in, scr, it, lane, gains);
            cvt_rows(x, XR, RS, gw, NGW, lane);
#endif
        } else if (ph == 2) {
#ifndef NO_MIX
            constexpr int NB = BATCH * 16, NA = MTOK / 64;
            for (int it = bx; it < NB + NA; it += G) {
                if (it < NB) mixerB_item(BIG, args.in[4], args.in[5], args.in[6], args.in[7], args.in[8], args.in[9], args.in[10], Yb, it, lds, tid);
                else mixerA_item(BIG, args.in[3], Yb, it - NB, tid);
            }
            {
                const int first = (G > NB) ? NB : 0;
                if (bx >= first) {
                    __syncthreads();
                    LAS float* scr = (LAS float*)(lds + wave * 16384);
                    constexpr int I_OUT = 32 * 64, I_QKV = 32 * 192, I_O = 32 * 64, I_UP = 32 * 256, I_DN = 128 * 64;
                    const int gw2 = (bx - first) * NWAVES + wave, NGW2 = (G - first) * NWAVES;
                    for (int it = gw2; it < I_OUT + I_QKV + I_O + 2 * I_UP + 2 * I_DN; it += NGW2) {
                        int r = it;
                        if (r < I_OUT) { p0_transpose_item(args.in[11], DM, DM, Wt_out, scr, r, lane); continue; } r -= I_OUT;
                        if (r < I_UP) { p0_transpose_item(args.in[14], DM, DFF, (bf16*)(ws + WS_WUP0), scr, r, lane, gains + 2 * DM); continue; } r -= I_UP;
                        if (r < I_DN) { p0_transpose_item(args.in[15], DFF, DM, (bf16*)(ws + WS_WDN0), scr, r, lane); continue; } r -= I_DN;
                        if (r < I_QKV) { p0_transpose_item(args.in[12], DM, NQKV, Wt_qkv, scr, r, lane, gains + 4 * DM); continue; } r -= I_QKV;
                        if (r < I_O) { p0_transpose_item(args.in[13], DM, DM, Wt_o, scr, r, lane); continue; } r -= I_O;
                        if (r < I_UP) { p0_transpose_item(args.in[14] + (size_t)DM * DFF, DM, DFF, (bf16*)(ws + WS_WUP1), scr, r, lane, gains + 6 * DM); continue; } r -= I_UP;
                        p0_transpose_item(args.in[15] + (size_t)DFF * DM, DFF, DM, (bf16*)(ws + WS_WDN1), scr, r, lane);
                    }
                }
            }
#endif
        } else if (ph == 9) {
#ifndef NO_ATTN
            if (G == 256) { for (int k = 0; k < 8; ++k) attn_unit(Qb, Kb, Vtb, Yb, (((k << 3) | (bx & 7)) << 5) | (bx >> 3), lds, tid); }
            else { for (int u = bx; u < BATCH * 8 * 32; u += G) attn_unit(Qb, Kb, Vtb, Yb, u, lds, tid); }
#endif
        } else {
#ifndef NO_POST
            const float* gpost = (ph == 4 || ph == 11) ? g + DM : g + 3 * DM;
            if (ph == 14) post_rows<true>(MIX, XR, out, gpost, RS, gw, NGW, lane); else post_rows<false>(MIX, XR, out, gpost, RS, gw, NGW, lane);
#endif
        }
        if (ph == 0) grid.sync(); else if (ph < 14) xcd_barrier(bar);
    }
}

extern "C" void kernel_launch(void* const* d_in, const int* in_sizes, int n_in, void* d_out, int out_size, void* d_ws, size_t ws_size, hipStream_t stream) {
    static int grid = 0;
    if (grid == 0) {
        if (n_in != 16 || in_sizes[0] != MTOK * DM || out_size != MTOK * DM || ws_size < WS_END) { fprintf(stderr, "kernel_launch: unexpected shapes / workspace (n_in %d, ws %zu); nothing launched\n", n_in, ws_size); grid = -1; return; }
        int dev = 0, cus = 0, per_cu = 0;
        if (hipGetDevice(&dev) != hipSuccess || hipDeviceGetAttribute(&cus, hipDeviceAttributeMultiprocessorCount, dev) != hipSuccess) { grid = -1; return; }
        if (hipFuncSetAttribute((const void*)mega_fwd, hipFuncAttributeMaxDynamicSharedMemorySize, LDS_BYTES) != hipSuccess) { fprintf(stderr, "kernel_launch: hipFuncSetAttribute failed\n"); grid = -1; return; }
        if (hipOccupancyMaxActiveBlocksPerMultiprocessor(&per_cu, (const void*)mega_fwd, NTHR, LDS_BYTES) != hipSuccess || per_cu < 1) { fprintf(stderr, "kernel_launch: occupancy query says %d\n", per_cu); per_cu = 1; }
        (void)hipGetLastError();
        grid = cus;
    }
    if (grid < 0) return;
    if (hipMemsetAsync((char*)d_ws + WS_CTL, 0, CTL_BYTES, stream) != hipSuccess) { fprintf(stderr, "kernel_launch: memset of the barrier words failed\n"); return; }
    Args a{};
    for (int i = 0; i < 16; ++i) a.in[i] = (const float*)d_in[i];
    a.out = (float*)d_out; a.ws = (unsigned char*)d_ws;
    void* kargs[] = {&a};
    hipError_t e = hipLaunchCooperativeKernel((const void*)mega_fwd, dim3(grid), dim3(NTHR), kargs, LDS_BYTES, stream);
    if (e != hipSuccess) fprintf(stderr, "kernel_launch: cooperative launch failed: %s (grid %d)\n", hipGetErrorString(e), grid);
}
```

```cpp
#include <hip/hip_runtime.h>
#include <hip/hip_cooperative_groups.h>
#include <cstdio>
#include <cstdint>
namespace cg = cooperative_groups;
namespace pg8 {
#define PG8_LAS __attribute__((address_space(3)))
typedef unsigned short bf16_t;
typedef short bf16x8 __attribute__((ext_vector_type(8)));
typedef float f32x4 __attribute__((ext_vector_type(4)));
typedef unsigned u32x4 __attribute__((ext_vector_type(4)));
constexpr int BM = 256, BK = 64, HALF = 128, HTB = HALF * BK * 2  , STAGE_BYTES = 8 * HTB, NXCD = 8, WGM = 8;

__host__ __device__ __forceinline__ int lds_byte(int r, int c) { const int st = (r >> 4) * 2 + (c >> 5), rr = r & 15, cc = c & 31, ob = rr * 64 + cc * 2; return st * 1024 + (ob ^ (((ob >> 9) & 1) << 5)); }
__host__ __device__ __forceinline__ void stage_rc(int b, int& R, int& C) { const int st = b / 1024, sb = b % 1024, swz = sb ^ (((sb >> 9) & 1) << 5); R = (st >> 1) * 16 + swz / 64; C = (st & 1) * 32 + (swz % 64) / 2; }
__host__ __device__ __forceinline__ int perm32(int rho) { const int n = rho >> 4, i = rho & 15; return 8 * (i >> 2) + 4 * n + (i & 3); }

struct Unit { int pm, pn; };
struct Gemm { const bf16_t* A; const bf16_t* Bt; int M, N, K; };

struct StaticOrder {
    int nM, nN, nwg, G, c;
    __host__ __device__ void init(int M, int N, int G_, int c_) { nM = M / BM; nN = N / BM; nwg = nM * nN; G = G_; c = c_; }
    __host__ __device__ bool next(int i, Unit& u) const {
        const long L = (long)i * G + c; if (L >= nwg) return false;
        int wgid = (int)L; { const int q = nwg / NXCD, r = nwg % NXCD, xcd = wgid % NXCD, off = wgid / NXCD; wgid = (xcd < r ? xcd * (q + 1) : r * (q + 1) + (xcd - r) * q) + off; }
        const int nig = WGM * nN, gid = wgid / nig, fm = gid * WGM, gsz = (nM - fm) < WGM ? (nM - fm) : WGM;
        u.pm = fm + ((wgid % nig) % gsz); u.pn = (wgid % nig) / gsz; return true;
    }
    __device__ __forceinline__ void a_ready(const Unit&) const {}
    __device__ __forceinline__ void done(const Unit&) const {}
};
__device__ __forceinline__ unsigned cvt_pk_bf16(float lo, float hi) { unsigned r; asm volatile("v_cvt_pk_bf16_f32 %0, %1, %2" : "=v"(r) : "v"(lo), "v"(hi)); return r; }
typedef float f32x2 __attribute__((ext_vector_type(2)));
__device__ __forceinline__ unsigned short f2bf1(float f) { unsigned u = __builtin_bit_cast(unsigned, f); return (unsigned short)((u + 0x7fffu + ((u >> 16) & 1u)) >> 16); }

struct EpiGen {
    static constexpr bool PERM = true, AFTER_DRAIN = false;
    int mode; bf16_t* O; int ldc; bf16_t* K; bf16_t* Vt; float qscale; const float* rowscale;
    __device__ __forceinline__ void operator()(const f32x4 (&acc)[2][2][4][2], const Unit& u, int wr, int wc, int fr, int fq) const {
        const int t3 = u.pn >> 3;
        if (mode == 3 && t3 == 2) {
            const int cv0 = (u.pn - 16) * BM + wc * 32 + 8 * fq;
#pragma unroll
            for (int ai = 0; ai < 2; ++ai)
#pragma unroll
                for (int m = 0; m < 4; ++m) { const int r = u.pm * BM + ai * HALF + wr * 64 + m * 16 + fr; const int b = r >> 12, t = r & 4095; const float rsv = rowscale ? rowscale[r] : 1.f;
#pragma unroll
                    for (int bj = 0; bj < 2; ++bj)
#pragma unroll
                        for (int n = 0; n < 2; ++n)
#pragma unroll
                            for (int e = 0; e < 4; ++e) { const int cv = cv0 + bj * HALF + 4 * n + e; const int head = cv >> 7, d = cv & 127;
                                Vt[((size_t)((b * 16 + head) * 128 + d) << 12) + t] = f2bf1(acc[ai][bj][m][n][e] * rsv); } }
            return;
        }
        bf16_t* base = O; float sc = 1.f; int colt = u.pn * BM;
        if (mode == 3) { colt = (u.pn & 7) * BM; if (t3) base = K; else sc = qscale; }
        const bool sq = (mode == 2);
        const int row0 = u.pm * BM + wr * 64 + fr; const int col0 = colt + wc * 32 + 8 * fq;
#pragma unroll
        for (int ai = 0; ai < 2; ++ai)
#pragma unroll
            for (int m = 0; m < 4; ++m) { bf16_t* rowp = base + (size_t)(row0 + ai * HALF + m * 16) * ldc + col0; const float rsc = (rowscale ? rowscale[row0 + ai * HALF + m * 16] : 1.f) * sc;
#pragma unroll
                for (int bj = 0; bj < 2; ++bj) { f32x4 v0 = acc[ai][bj][m][0] * rsc, v1 = acc[ai][bj][m][1] * rsc;
                    if (sq) {
#pragma unroll
                        for (int e = 0; e < 4; ++e) { float a = v0[e] > 0.f ? v0[e] : 0.f; v0[e] = a * a; float b = v1[e] > 0.f ? v1[e] : 0.f; v1[e] = b * b; } }
                    u32x4 w; w.x = cvt_pk_bf16(v0[0], v0[1]); w.y = cvt_pk_bf16(v0[2], v0[3]); w.z = cvt_pk_bf16(v1[0], v1[1]); w.w = cvt_pk_bf16(v1[2], v1[3]);
                    *(u32x4*)(rowp + bj * HALF) = w; } }
    }
};

template <class Epi, class Sched, bool ALIGN_EPI = false, bool SP2 = false>
__device__ __forceinline__ void gemm_phase(PG8_LAS unsigned char* lds, const Gemm g, const Sched& S, const Epi& E) {
    int tid = threadIdx.x; asm volatile("" : "+v"(tid)); const int wid = __builtin_amdgcn_readfirstlane(tid >> 6), lane = tid & 63, wr = wid >> 2, wc = wid & 3, fr = lane & 15, fq = lane >> 4;
    const int K = g.K, nt = K / BK;
    unsigned voffA[2], voffB[2];
#pragma unroll
    for (int i = 0; i < 2; ++i) { int R, C; stage_rc(tid * 16 + i * 8192, R, C); const int Rb = Epi::PERM ? ((R & ~31) + perm32(R & 31)) : R;
        voffA[i] = (unsigned)(R * K + C) * 2u; voffB[i] = (unsigned)(Rb * K + C) * 2u; }
    const size_t kstep = (size_t)(BK * 2);
    const size_t hstep = (size_t)HALF * K * 2;
    const size_t tstep = 2 * hstep;
    const unsigned ldsw = (unsigned)wid * 1024u;
    const int aoff = lds_byte(wr * 64 + fr, fq * 8), boff = lds_byte(wc * 32 + fr, fq * 8);
#define PG8_SA(b, h) (((b) * 2 + (h)) * HTB)
#define PG8_SB(b, h) ((4 + (b) * 2 + (h)) * HTB)
#define PG8_STAGE(bufoff, gbase, voff) do { _Pragma("unroll") for (int _i = 0; _i < 2; ++_i) \
        __builtin_amdgcn_global_load_lds((const unsigned*)((const char*)(gbase) + (voff)[_i]), (PG8_LAS unsigned*)(lds + (bufoff) + ldsw + _i * 8192), 16, 0, 0); } while (0)
#define PG8_LDA(dst, b, h) do { _Pragma("unroll") for (int m = 0; m < 4; ++m) _Pragma("unroll") for (int k = 0; k < 2; ++k) dst[m][k] = *(const PG8_LAS bf16x8*)(lds + PG8_SA(b, h) + aoff + m * 2048 + k * 1024); } while (0)
#define PG8_LDB(dst, b, h) do { _Pragma("unroll") for (int n = 0; n < 2; ++n) _Pragma("unroll") for (int k = 0; k < 2; ++k) dst[n][k] = *(const PG8_LAS bf16x8*)(lds + PG8_SB(b, h) + boff + n * 2048 + k * 1024); } while (0)
#define PG8_MMA(ai, bj, At, Bt) do { __builtin_amdgcn_s_setprio(1); _Pragma("unroll") for (int m = 0; m < 4; ++m) _Pragma("unroll") for (int n = 0; n < 2; ++n) _Pragma("unroll") for (int k = 0; k < 2; ++k) \
        acc[ai][bj][m][n] = __builtin_amdgcn_mfma_f32_16x16x32_bf16(Bt[n][k], At[m][k], acc[ai][bj][m][n], 0, 0, 0); __builtin_amdgcn_s_setprio(0); } while (0)
#define PG8_WAIT_V(n) asm volatile("s_waitcnt vmcnt(" #n ")" ::: "memory")
#define PG8_WAIT_L(n) asm volatile("s_waitcnt lgkmcnt(" #n ")" ::: "memory")
#define PG8_BAR __builtin_amdgcn_s_barrier()
#define PG8_SCHED __builtin_amdgcn_sched_barrier(0)
    Unit cur, nxt; int ui = 0;
    if (!S.next(0, cur)) return;
    f32x4 acc[2][2][4][2];
#pragma unroll
    for (int a = 0; a < 2; ++a)
#pragma unroll
        for (int b = 0; b < 2; ++b)
#pragma unroll
            for (int m = 0; m < 4; ++m)
#pragma unroll
                for (int n = 0; n < 2; ++n) acc[a][b][m][n] = (f32x4){0.f, 0.f, 0.f, 0.f};
    bf16x8 At[4][2], B0[2][2], B1[2][2];
    const char* cA = (const char*)g.A + (size_t)cur.pm * tstep; const char* cB = (const char*)g.Bt + (size_t)cur.pn * tstep;
    S.a_ready(cur);
    if constexpr (SP2) {
        PG8_STAGE(PG8_SB(0, 0), cB, voffB); PG8_STAGE(PG8_SB(0, 1), cB + hstep, voffB); PG8_STAGE(PG8_SA(0, 0), cA, voffA); PG8_STAGE(PG8_SA(0, 1), cA + hstep, voffA);
        if (wr == 1) PG8_BAR;
        PG8_WAIT_V(2); PG8_BAR;
        PG8_STAGE(PG8_SB(1, 0), cB + kstep, voffB); PG8_STAGE(PG8_SA(1, 0), cA + kstep, voffA); PG8_STAGE(PG8_SB(1, 1), cB + hstep + kstep, voffB);
        PG8_WAIT_V(6); PG8_BAR;
    } else {
        PG8_STAGE(PG8_SB(0, 0), cB, voffB); PG8_STAGE(PG8_SA(0, 0), cA, voffA); PG8_STAGE(PG8_SB(0, 1), cB + hstep, voffB); PG8_STAGE(PG8_SA(0, 1), cA + hstep, voffA);
        if (wr == 1) PG8_BAR;
        PG8_WAIT_V(4); PG8_BAR;
        PG8_STAGE(PG8_SB(1, 0), cB + kstep, voffB); PG8_STAGE(PG8_SA(1, 0), cA + kstep, voffA); PG8_STAGE(PG8_SB(1, 1), cB + hstep + kstep, voffB);
        PG8_WAIT_V(6); PG8_BAR;
    }
    for (;;) {
        const bool has_next = S.next(ui + 1, nxt);
        const char* nA = has_next ? (const char*)g.A + (size_t)nxt.pm * tstep : cA; const char* nB = has_next ? (const char*)g.Bt + (size_t)nxt.pn * tstep : cB;
        for (int t = 0; t < nt; t += 2) {
            const bool last = (t == nt - 2);
            const char* a1 = cA + (size_t)(t + 1) * kstep;
            const char* a2 = last ? nA : cA + (size_t)(t + 2) * kstep; const char* b2 = last ? nB : cB + (size_t)(t + 2) * kstep;
            const char* a3 = a2 + kstep; const char* b3 = b2 + kstep;
            if (last && has_next) S.a_ready(nxt);
            if constexpr (SP2) {
            PG8_LDB(B0, 0, 0); PG8_LDB(B1, 0, 1); PG8_SCHED; PG8_LDA(At, 0, 0); PG8_STAGE(PG8_SA(1, 1), a1 + hstep, voffA);
            PG8_WAIT_V(8); PG8_WAIT_L(0); PG8_BAR; PG8_MMA(0, 0, At, B0); PG8_MMA(0, 1, At, B1); PG8_BAR; PG8_SCHED;
            PG8_LDA(At, 0, 1); PG8_STAGE(PG8_SB(0, 0), b2, voffB); PG8_STAGE(PG8_SB(0, 1), b2 + hstep, voffB); PG8_STAGE(PG8_SA(0, 0), a2, voffA);
            PG8_WAIT_V(8); PG8_WAIT_L(0); PG8_BAR; PG8_MMA(1, 0, At, B0); PG8_MMA(1, 1, At, B1); PG8_BAR; PG8_SCHED;
            PG8_LDB(B0, 1, 0); PG8_LDB(B1, 1, 1); PG8_SCHED; PG8_LDA(At, 1, 0); PG8_STAGE(PG8_SA(0, 1), a2 + hstep, voffA);
            PG8_WAIT_V(8); PG8_WAIT_L(0); PG8_BAR; PG8_MMA(0, 0, At, B0); PG8_MMA(0, 1, At, B1); PG8_BAR; PG8_SCHED;
            PG8_LDA(At, 1, 1); PG8_STAGE(PG8_SB(1, 0), b3, voffB); PG8_STAGE(PG8_SB(1, 1), b3 + hstep, voffB); PG8_STAGE(PG8_SA(1, 0), a3, voffA);
            PG8_WAIT_V(8); PG8_WAIT_L(0); PG8_BAR; PG8_MMA(1, 0, At, B0); PG8_MMA(1, 1, At, B1); PG8_BAR; PG8_SCHED;
            } else {
            PG8_LDB(B0, 0, 0); PG8_SCHED; PG8_LDA(At, 0, 0); PG8_STAGE(PG8_SA(1, 1), a1 + hstep, voffA);
            PG8_WAIT_L(8); PG8_BAR; PG8_WAIT_L(0); PG8_MMA(0, 0, At, B0); PG8_BAR; PG8_SCHED;
            PG8_LDB(B1, 0, 1); PG8_STAGE(PG8_SB(0, 0), b2, voffB);
            PG8_BAR; PG8_WAIT_L(0); PG8_MMA(0, 1, At, B1); PG8_BAR;
            PG8_LDA(At, 0, 1); PG8_STAGE(PG8_SA(0, 0), a2, voffA);
            PG8_BAR; PG8_WAIT_L(0); PG8_MMA(1, 0, At, B0); PG8_BAR; PG8_SCHED;
            PG8_STAGE(PG8_SB(0, 1), b2 + hstep, voffB);
            PG8_WAIT_V(6); PG8_BAR; PG8_MMA(1, 1, At, B1); PG8_BAR;
            PG8_LDB(B0, 1, 0); PG8_SCHED; PG8_LDA(At, 1, 0); PG8_STAGE(PG8_SA(0, 1), a2 + hstep, voffA);
            PG8_WAIT_L(8); PG8_BAR; PG8_WAIT_L(0); PG8_MMA(0, 0, At, B0); PG8_BAR; PG8_SCHED;
            PG8_LDB(B1, 1, 1); PG8_STAGE(PG8_SB(1, 0), b3, voffB);
            PG8_BAR; PG8_WAIT_L(0); PG8_MMA(0, 1, At, B1); PG8_BAR;
            PG8_LDA(At, 1, 1); PG8_STAGE(PG8_SA(1, 0), a3, voffA);
            PG8_BAR; PG8_WAIT_L(0); PG8_MMA(1, 0, At, B0); PG8_BAR; PG8_SCHED;
            PG8_STAGE(PG8_SB(1, 1), b3 + hstep, voffB);
            PG8_WAIT_V(6); PG8_BAR; PG8_MMA(1, 1, At, B1); PG8_BAR;
            }
        }
        if constexpr (ALIGN_EPI) { if (wr == 0) PG8_BAR; }
        if constexpr (!Epi::AFTER_DRAIN) { E(acc, cur, wr, wc, fr, fq); S.done(cur); }
        if (!has_next) break;
#pragma unroll
        for (int a = 0; a < 2; ++a)
#pragma unroll
            for (int b = 0; b < 2; ++b)
#pragma unroll
                for (int m = 0; m < 4; ++m)
#pragma unroll
                    for (int n = 0; n < 2; ++n) acc[a][b][m][n] = (f32x4){0.f, 0.f, 0.f, 0.f};
        cur = nxt; cA = nA; cB = nB; ++ui;
        if constexpr (ALIGN_EPI) { if (wr == 1) PG8_BAR; }
    }
    PG8_WAIT_V(0);
    if constexpr (!ALIGN_EPI) { if (wr == 0) PG8_BAR; }
    PG8_BAR;
    if constexpr (Epi::AFTER_DRAIN) { E.fused(acc, cur, wr, wc, fr, fq, lds, wid, lane); S.done(cur); }
#undef PG8_SA
#undef PG8_SB
#undef PG8_STAGE
#undef PG8_LDA
#undef PG8_LDB
#undef PG8_MMA
#undef PG8_WAIT_V
#undef PG8_WAIT_L
#undef PG8_BAR
#undef PG8_SCHED
}
}
#define LAS __attribute__((address_space(3)))
typedef unsigned short bf16;
typedef unsigned v4u __attribute__((ext_vector_type(4)));
typedef unsigned v2u __attribute__((ext_vector_type(2)));
typedef float f32x4 __attribute__((ext_vector_type(4)));
typedef float f32x16 __attribute__((ext_vector_type(16)));
typedef short bf16x8 __attribute__((ext_vector_type(8)));
constexpr int NWAVES = 8, NTHR = 512;
constexpr int BATCH = 8, SEQ = 4096, DM = 2048, MTOK = BATCH * SEQ, DIN = 5120, DFF = 8192, NQKV = 6144;
constexpr float NORM_EPS = 1e-6f;
constexpr size_t MiB = 1u << 20;
constexpr size_t WS_WIN = 0, WS_WOUT = 20 * MiB, WS_WQKV = 28 * MiB, WS_WO = 52 * MiB, WS_WUP0 = 60 * MiB, WS_WUP1 = 92 * MiB, WS_WDN0 = 124 * MiB, WS_WDN1 = 156 * MiB;
constexpr size_t WS_H = 192 * MiB, WS_MIX = 320 * MiB, WS_BIG = 448 * MiB, WS_CTL = 960 * MiB, CTL_BYTES = 16384, WS_RS = 960 * MiB + 65536, WS_END = 961 * MiB;
constexpr int LDS_MISC = 131072, LDS_BYTES = 131072 + 256;

__device__ __forceinline__ float bflo(unsigned u) { return __uint_as_float(u << 16); }
__device__ __forceinline__ float bfhi(unsigned u) { return __uint_as_float(u & 0xffff0000u); }
__device__ __forceinline__ unsigned pk2(float lo, float hi) { return pg8::cvt_pk_bf16(lo, hi); }
__device__ __forceinline__ float wave_sum(float v) {
#pragma unroll
    for (int o = 1; o < 64; o <<= 1) v += __shfl_xor(v, o);
    return v;
}
#define LDS_BARRIER() do { asm volatile("s_waitcnt lgkmcnt(0)" ::: "memory"); __builtin_amdgcn_s_barrier(); asm volatile("" ::: "memory"); } while (0)
__device__ __forceinline__ float fsigmoid(float x) { return __builtin_amdgcn_rcpf(1.f + __expf(-x)); }

__device__ __forceinline__ void p0_transpose_item(const float* W, int K, int N, bf16* WT, LAS float* scr, int item, int lane, const float* gk = nullptr) {
    const int nblk = N / 32, kb = item / nblk, nb = item % nblk, k0 = 64 * kb, n0 = 32 * nb;
    float tv[32];
#pragma unroll
    for (int i = 0; i < 32; ++i) tv[i] = W[(size_t)(k0 + 2 * i + (lane >> 5)) * N + n0 + (lane & 31)];
#pragma unroll
    for (int i = 0; i < 32; ++i) scr[(2 * i + (lane >> 5)) * 33 + (lane & 31)] = tv[i];
    asm volatile("s_waitcnt lgkmcnt(0)" ::: "memory");
    const int c = lane & 7;
    f32x4 g0 = {1.f, 1.f, 1.f, 1.f}, g1 = {1.f, 1.f, 1.f, 1.f};
    if (gk) { g0 = *(const f32x4*)(gk + k0 + 8 * c); g1 = *(const f32x4*)(gk + k0 + 8 * c + 4); }
#pragma unroll
    for (int j = 0; j < 4; ++j) { const int n = (lane >> 3) + 8 * j; const LAS float* s = scr + (8 * c) * 33 + n;
        v4u o; o.x = pk2(s[0 * 33] * g0.x, s[1 * 33] * g0.y); o.y = pk2(s[2 * 33] * g0.z, s[3 * 33] * g0.w); o.z = pk2(s[4 * 33] * g1.x, s[5 * 33] * g1.y); o.w = pk2(s[6 * 33] * g1.z, s[7 * 33] * g1.w);
        *(v4u*)(WT + (size_t)(n0 + n) * K + k0 + 8 * c) = o; }
    asm volatile("s_waitcnt lgkmcnt(0)" ::: "memory");
}

__device__ __forceinline__ void cvt_row(const float* xrow, bf16* orow, float* rs, int lane) {
    f32x4 v[4][2]; float ss = 0.f;
#pragma unroll
    for (int j = 0; j < 4; ++j)
#pragma unroll
        for (int e = 0; e < 2; ++e) { v[j][e] = *(const f32x4*)(xrow + 512 * j + 8 * lane + 4 * e); ss += (v[j][e].x * v[j][e].x + v[j][e].y * v[j][e].y) + (v[j][e].z * v[j][e].z + v[j][e].w * v[j][e].w); }
    const float r = __builtin_amdgcn_rsqf(wave_sum(ss) * (1.f / DM) + NORM_EPS);
#pragma unroll
    for (int j = 0; j < 4; ++j) { const f32x4 a = v[j][0], b = v[j][1];
        v4u o; o.x = pk2(a.x, a.y); o.y = pk2(a.z, a.w); o.z = pk2(b.x, b.y); o.w = pk2(b.z, b.w);
        *(v4u*)(orow + 512 * j + 8 * lane) = o; }
    if (lane == 0) *rs = r;
}

template <bool XIN_F32, bool OUT_F32>
__device__ __forceinline__ void post_row(const bf16* mrow, const float* xin_f, const bf16* xin_b, float* xout_f, bf16* xout_b, const float* gpost, float* rs, int lane) {
    f32x4 mv[4][2], xv[4][2], gp[4][2]; float ss = 0.f;
    v4u r[4], xr[4];
#pragma unroll
    for (int j = 0; j < 4; ++j) r[j] = *(const v4u*)(mrow + 512 * j + 8 * lane);
    if (XIN_F32) {
#pragma unroll
        for (int j = 0; j < 4; ++j)
#pragma unroll
            for (int e = 0; e < 2; ++e) xv[j][e] = *(const f32x4*)(xin_f + 512 * j + 8 * lane + 4 * e);
    } else {
#pragma unroll
        for (int j = 0; j < 4; ++j) xr[j] = *(const v4u*)(xin_b + 512 * j + 8 * lane);
#pragma unroll
        for (int j = 0; j < 4; ++j) { xv[j][0] = (f32x4){bflo(xr[j].x), bfhi(xr[j].x), bflo(xr[j].y), bfhi(xr[j].y)}; xv[j][1] = (f32x4){bflo(xr[j].z), bfhi(xr[j].z), bflo(xr[j].w), bfhi(xr[j].w)}; }
    }
#pragma unroll
    for (int j = 0; j < 4; ++j)
#pragma unroll
        for (int e = 0; e < 2; ++e) gp[j][e] = *(const f32x4*)(gpost + 512 * j + 8 * lane + 4 * e);
#pragma unroll
    for (int j = 0; j < 4; ++j) {
        mv[j][0] = (f32x4){bflo(r[j].x), bfhi(r[j].x), bflo(r[j].y), bfhi(r[j].y)}; mv[j][1] = (f32x4){bflo(r[j].z), bfhi(r[j].z), bflo(r[j].w), bfhi(r[j].w)};
#pragma unroll
        for (int e = 0; e < 2; ++e) ss += (mv[j][e].x * mv[j][e].x + mv[j][e].y * mv[j][e].y) + (mv[j][e].z * mv[j][e].z + mv[j][e].w * mv[j][e].w); }
    const float rs1 = __builtin_amdgcn_rsqf(wave_sum(ss) * (1.f / DM) + NORM_EPS);
    float s2 = 0.f;
#pragma unroll
    for (int j = 0; j < 4; ++j)
#pragma unroll
        for (int e = 0; e < 2; ++e) { const f32x4 x1 = xv[j][e] + mv[j][e] * rs1 * gp[j][e]; mv[j][e] = x1; s2 += (x1.x * x1.x + x1.y * x1.y) + (x1.z * x1.z + x1.w * x1.w); }
    if (OUT_F32) {
#pragma unroll
        for (int j = 0; j < 4; ++j)
#pragma unroll
            for (int e = 0; e < 2; ++e) *(f32x4*)(xout_f + 512 * j + 8 * lane + 4 * e) = mv[j][e];
    } else {
#pragma unroll
        for (int j = 0; j < 4; ++j) { const f32x4 a = mv[j][0], b = mv[j][1];
            v4u o; o.x = pk2(a.x, a.y); o.y = pk2(a.z, a.w); o.z = pk2(b.x, b.y); o.w = pk2(b.z, b.w);
            *(v4u*)(xout_b + 512 * j + 8 * lane) = o; }
        const float rs2 = __builtin_amdgcn_rsqf(wave_sum(s2) * (1.f / DM) + NORM_EPS);
        if (lane == 0) *rs = rs2;
    }
}

template <bool OUT_F32>
__device__ __forceinline__ void post_rows(const bf16* MIXb, bf16* XRb, float* outf, const float* gpost, float* RSb, int gw, int NGW, int lane) {
    f32x4 gp[4][2];
#pragma unroll
    for (int j = 0; j < 4; ++j)
#pragma unroll
        for (int e = 0; e < 2; ++e) gp[j][e] = *(const f32x4*)(gpost + 512 * j + 8 * lane + 4 * e);
    v4u nr[4], nx[4];
#pragma unroll
    for (int j = 0; j < 4; ++j) { nr[j] = *(const v4u*)(MIXb + (size_t)gw * DM + 512 * j + 8 * lane); nx[j] = *(const v4u*)(XRb + (size_t)gw * DM + 512 * j + 8 * lane); }
    for (int m = gw; m < MTOK; m += NGW) {
        v4u r[4], xr[4];
#pragma unroll
        for (int j = 0; j < 4; ++j) { r[j] = nr[j]; xr[j] = nx[j]; }
        const int mn = m + NGW;
        if (mn < MTOK) {
#pragma unroll
            for (int j = 0; j < 4; ++j) { nr[j] = *(const v4u*)(MIXb + (size_t)mn * DM + 512 * j + 8 * lane); nx[j] = *(const v4u*)(XRb + (size_t)mn * DM + 512 * j + 8 * lane); } }
        f32x4 mv[4][2]; float ss = 0.f;
#pragma unroll
        for (int j = 0; j < 4; ++j) {
            mv[j][0] = (f32x4){bflo(r[j].x), bfhi(r[j].x), bflo(r[j].y), bfhi(r[j].y)}; mv[j][1] = (f32x4){bflo(r[j].z), bfhi(r[j].z), bflo(r[j].w), bfhi(r[j].w)};
#pragma unroll
            for (int e = 0; e < 2; ++e) ss += (mv[j][e].x * mv[j][e].x + mv[j][e].y * mv[j][e].y) + (mv[j][e].z * mv[j][e].z + mv[j][e].w * mv[j][e].w); }
        const float rs1 = __builtin_amdgcn_rsqf(wave_sum(ss) * (1.f / DM) + NORM_EPS);
        float s2 = 0.f;
#pragma unroll
        for (int j = 0; j < 4; ++j) {
            const f32x4 x0 = (f32x4){bflo(xr[j].x), bfhi(xr[j].x), bflo(xr[j].y), bfhi(xr[j].y)}, x1 = (f32x4){bflo(xr[j].z), bfhi(xr[j].z), bflo(xr[j].w), bfhi(xr[j].w)};
            const f32x4 a = x0 + mv[j][0] * rs1 * gp[j][0], b = x1 + mv[j][1] * rs1 * gp[j][1]; mv[j][0] = a; mv[j][1] = b;
            s2 += ((a.x * a.x + a.y * a.y) + (a.z * a.z + a.w * a.w)) + ((b.x * b.x + b.y * b.y) + (b.z * b.z + b.w * b.w)); }
        if (OUT_F32) {
#pragma unroll
            for (int j = 0; j < 4; ++j)
#pragma unroll
                for (int e = 0; e < 2; ++e) *(f32x4*)(outf + (size_t)m * DM + 512 * j + 8 * lane + 4 * e) = mv[j][e];
        } else {
#pragma unroll
            for (int j = 0; j < 4; ++j) { const f32x4 a = mv[j][0], b = mv[j][1];
                v4u o; o.x = pk2(a.x, a.y); o.y = pk2(a.z, a.w); o.z = pk2(b.x, b.y); o.w = pk2(b.z, b.w);
                *(v4u*)(XRb + (size_t)m * DM + 512 * j + 8 * lane) = o; }
            const float rs2 = __builtin_amdgcn_rsqf(wave_sum(s2) * (1.f / DM) + NORM_EPS);
            if (lane == 0) RSb[m] = rs2;
        }
    }
}

__device__ __forceinline__ void cvt_rows(const float* x, bf16* XRb, float* RSb, int gw, int NGW, int lane) {
    f32x4 nv[4][2];
#pragma unroll
    for (int j = 0; j < 4; ++j)
#pragma unroll
        for (int e = 0; e < 2; ++e) nv[j][e] = *(const f32x4*)(x + (size_t)gw * DM + 512 * j + 8 * lane + 4 * e);
    for (int m = gw; m < MTOK; m += NGW) {
        f32x4 v[4][2]; float ss = 0.f;
#pragma unroll
        for (int j = 0; j < 4; ++j)
#pragma unroll
            for (int e = 0; e < 2; ++e) v[j][e] = nv[j][e];
        const int mn = m + NGW;
        if (mn < MTOK) {
#pragma unroll
            for (int j = 0; j < 4; ++j)
#pragma unroll
                for (int e = 0; e < 2; ++e) nv[j][e] = *(const f32x4*)(x + (size_t)mn * DM + 512 * j + 8 * lane + 4 * e); }
#pragma unroll
        for (int j = 0; j < 4; ++j)
#pragma unroll
            for (int e = 0; e < 2; ++e) ss += (v[j][e].x * v[j][e].x + v[j][e].y * v[j][e].y) + (v[j][e].z * v[j][e].z + v[j][e].w * v[j][e].w);
        const float r = __builtin_amdgcn_rsqf(wave_sum(ss) * (1.f / DM) + NORM_EPS);
#pragma unroll
        for (int j = 0; j < 4; ++j) { const f32x4 a = v[j][0], b = v[j][1];
            v4u o; o.x = pk2(a.x, a.y); o.y = pk2(a.z, a.w); o.z = pk2(b.x, b.y); o.w = pk2(b.z, b.w);
            *(v4u*)(XRb + (size_t)m * DM + 512 * j + 8 * lane) = o; }
        if (lane == 0) RSb[m] = r;
    }
}

__device__ __forceinline__ void mixerA_item(const bf16* proj, const float* conv_a, bf16* Y, int item, int tid) {
    const int cgp = tid & 127, tg = tid >> 7, c0 = 8 * cgp;
    const int row0 = item * 64 + tg * 16, t0 = row0 & (SEQ - 1);
    float w0[8], w1[8], w2[8], u1[8], u2[8];
#pragma unroll
    for (int e = 0; e < 8; ++e) { w0[e] = conv_a[c0 + e]; w1[e] = conv_a[1024 + c0 + e]; w2[e] = conv_a[2048 + c0 + e]; u1[e] = 0.f; u2[e] = 0.f; }
    if (t0 != 0) {
        const v4u c2 = *(const v4u*)(proj + (size_t)(row0 - 2) * DIN + 1024 + c0), x2 = *(const v4u*)(proj + (size_t)(row0 - 2) * DIN + 2048 + c0);
        const v4u c1 = *(const v4u*)(proj + (size_t)(row0 - 1) * DIN + 1024 + c0), x1 = *(const v4u*)(proj + (size_t)(row0 - 1) * DIN + 2048 + c0);
#pragma unroll
        for (int q = 0; q < 4; ++q) { u2[2 * q] = bflo(c2[q]) * bflo(x2[q]); u2[2 * q + 1] = bfhi(c2[q]) * bfhi(x2[q]); u1[2 * q] = bflo(c1[q]) * bflo(x1[q]); u1[2 * q + 1] = bfhi(c1[q]) * bfhi(x1[q]); }
    }
    for (int i0 = 0; i0 < 16; i0 += 4) {
        v4u bg[4], cgv[4], ax[4];
#pragma unroll
        for (int i = 0; i < 4; ++i) { const bf16* p = proj + (size_t)(row0 + i0 + i) * DIN + c0; bg[i] = *(const v4u*)p; cgv[i] = *(const v4u*)(p + 1024); ax[i] = *(const v4u*)(p + 2048); }
#pragma unroll
        for (int i = 0; i < 4; ++i) {
            float u0[8], y[8];
#pragma unroll
            for (int q = 0; q < 4; ++q) { u0[2 * q] = bflo(cgv[i][q]) * bflo(ax[i][q]); u0[2 * q + 1] = bfhi(cgv[i][q]) * bfhi(ax[i][q]); }
#pragma unroll
            for (int q = 0; q < 4; ++q) { y[2 * q] = bflo(bg[i][q]) * (w0[2 * q] * u2[2 * q] + w1[2 * q] * u1[2 * q] + w2[2 * q] * u0[2 * q]);
                y[2 * q + 1] = bfhi(bg[i][q]) * (w0[2 * q + 1] * u2[2 * q + 1] + w1[2 * q + 1] * u1[2 * q + 1] + w2[2 * q + 1] * u0[2 * q + 1]); }
            v4u o; o.x = pk2(y[0], y[1]); o.y = pk2(y[2], y[3]); o.z = pk2(y[4], y[5]); o.w = pk2(y[6], y[7]);
            *(v4u*)(Y + (size_t)(row0 + i0 + i) * DM + c0) = o;
#pragma unroll
            for (int e = 0; e < 8; ++e) { u2[e] = u1[e]; u1[e] = u0[e]; }
        }
    }
}

template <int SHR> __device__ __forceinline__ float dpp_shr(float oldv, float src) {
    return __builtin_bit_cast(float, __builtin_amdgcn_update_dpp(__builtin_bit_cast(int, oldv), __builtin_bit_cast(int, src), 0x110 + SHR, 0xf, 0xf, false));
}
template <int SHR> __device__ __forceinline__ void scan_step(float (&av)[16], float (&bv)[16]) {
#pragma unroll
    for (int i = 0; i < 16; ++i) { const float ap = dpp_shr<SHR>(1.f, av[i]); const float bp = dpp_shr<SHR>(0.f, bv[i]); bv[i] = av[i] * bp + bv[i]; av[i] = av[i] * ap; }
}
__device__ __forceinline__ void mixerB_item(const bf16* proj, const float* conv_b, const float* conv_b_bias, const float* w_a, const float* b_a, const float* w_x, const float* b_x,
                                            const float* lam, bf16* Y, int item, LAS unsigned char* lds, int tid) {
    const int b = item >> 4, hd = item & 15;
    const int lane = tid & 63, w = __builtin_amdgcn_readfirstlane(tid >> 6), fr = lane & 15, fq = lane >> 4;
    LAS float* cst = (LAS float*)lds;
    LAS float* agg = cst + 512;
    __syncthreads();
    { const int k = tid >> 6, c = tid & 63, ch = hd * 64 + c; float v;
      if (k < 4) v = conv_b[k * 1024 + ch]; else if (k == 4) v = conv_b_bias[ch]; else if (k == 5) v = b_a[ch]; else if (k == 6) v = b_x[ch];
      else { const float l = lam[ch]; v = 8.f * (fminf(l, 0.f) - log1pf(__expf(-fabsf(l)))); }
      cst[k * 64 + c] = v; }
    LAS unsigned char* wf = lds + 10240;
    {
#pragma unroll
        for (int q = 0; q < 2; ++q) { const int fi = w * 2 + q, mat = fi >> 3, mt = (fi >> 1) & 3, s = fi & 1; const float* wsrc = mat ? w_x : w_a; bf16x8 fragv;
#pragma unroll
            for (int jj = 0; jj < 8; ++jj) { const int idx = 8 * s + jj; const int i = 16 * (idx >> 2) + 4 * fq + (idx & 3); const int j = 16 * mt + fr;
                fragv[jj] = (short)pg8::f2bf1(wsrc[(size_t)(hd * 64 + i) * 64 + j]); }
            *(LAS bf16x8*)(wf + fi * 1024 + lane * 16) = fragv; }
    }
    __syncthreads();
    float hc[16];
#pragma unroll
    for (int i = 0; i < 16; ++i) hc[i] = 0.f;
    const bf16* pbx = proj + (size_t)(b * SEQ) * DIN + 4096 + hd * 64 + 4 * fq;
    const bf16* pgt = proj + (size_t)(b * SEQ) * DIN + 3072 + hd * 64 + 4 * fq;
    bf16* py = Y + (size_t)(b * SEQ) * DM + 1024 + hd * 64 + 4 * fq;
    v2u nraw[4][4], ngraw[4];
#define MB_LOAD(cc) do { const int t_ = (cc) * 128 + w * 16 + fr; _Pragma("unroll") for (int k = 0; k < 4; ++k) { const int tok = t_ - 3 + k; \
        _Pragma("unroll") for (int g = 0; g < 4; ++g) { nraw[k][g] = (v2u){0u, 0u}; if (tok >= 0) nraw[k][g] = *(const v2u*)(pbx + (size_t)tok * DIN + 16 * g); } } \
        _Pragma("unroll") for (int g = 0; g < 4; ++g) ngraw[g] = *(const v2u*)(pgt + (size_t)t_ * DIN + 16 * g); } while (0)
    MB_LOAD(0);
    for (int c = 0; c < SEQ / 128; ++c) {
        asm volatile("" ::: "memory");
        const int t = c * 128 + w * 16 + fr;
        v2u raw[4][4], graw[4];
#pragma unroll
        for (int k = 0; k < 4; ++k)
#pragma unroll
            for (int g = 0; g < 4; ++g) raw[k][g] = nraw[k][g];
#pragma unroll
        for (int g = 0; g < 4; ++g) graw[g] = ngraw[g];
        if (c + 1 < SEQ / 128) MB_LOAD(c + 1);
        float xr[16];
#pragma unroll
        for (int g = 0; g < 4; ++g) { f32x4 acc = *(const LAS f32x4*)(cst + 4 * 64 + 16 * g + 4 * fq);
#pragma unroll
            for (int k = 0; k < 4; ++k) { const f32x4 wk = *(const LAS f32x4*)(cst + k * 64 + 16 * g + 4 * fq);
                acc.x += wk.x * bflo(raw[k][g].x); acc.y += wk.y * bfhi(raw[k][g].x); acc.z += wk.z * bflo(raw[k][g].y); acc.w += wk.w * bfhi(raw[k][g].y); }
            xr[4 * g] = acc.x; xr[4 * g + 1] = acc.y; xr[4 * g + 2] = acc.z; xr[4 * g + 3] = acc.w; }
        bf16x8 xb[2];
#pragma unroll
        for (int s = 0; s < 2; ++s) { const unsigned p0 = pk2(xr[8 * s], xr[8 * s + 1]), p1 = pk2(xr[8 * s + 2], xr[8 * s + 3]), p2 = pk2(xr[8 * s + 4], xr[8 * s + 5]), p3 = pk2(xr[8 * s + 6], xr[8 * s + 7]);
            xb[s] = __builtin_bit_cast(bf16x8, (v4u){p0, p1, p2, p3}); }
        float av[16], bv[16];
#pragma unroll
        for (int mt = 0; mt < 4; ++mt) { f32x4 ga = {0.f, 0.f, 0.f, 0.f}, gx = {0.f, 0.f, 0.f, 0.f};
            asm volatile("" : "+v"(ga), "+v"(gx));
#pragma unroll
            for (int s = 0; s < 2; ++s) { const bf16x8 wa_ = *(const LAS bf16x8*)(wf + (mt * 2 + s) * 1024 + lane * 16), wx_ = *(const LAS bf16x8*)(wf + (8 + mt * 2 + s) * 1024 + lane * 16);
                ga = __builtin_amdgcn_mfma_f32_16x16x32_bf16(wa_, xb[s], ga, 0, 0, 0); gx = __builtin_amdgcn_mfma_f32_16x16x32_bf16(wx_, xb[s], gx, 0, 0, 0); }
            const f32x4 ba4 = *(const LAS f32x4*)(cst + 5 * 64 + 16 * mt + 4 * fq), bx4 = *(const LAS f32x4*)(cst + 6 * 64 + 16 * mt + 4 * fq), cl4 = *(const LAS f32x4*)(cst + 7 * 64 + 16 * mt + 4 * fq);
#pragma unroll
            for (int r = 0; r < 4; ++r) { const float ra = fsigmoid(ga[r] + ba4[r]), ia = fsigmoid(gx[r] + bx4[r]); const float la = cl4[r] * ra;
                const float a = __expf(la); const float m2 = fmaxf(1.f - __expf(2.f * la), 0.f);
                av[4 * mt + r] = a; bv[4 * mt + r] = __builtin_amdgcn_sqrtf(m2) * ia * xr[4 * mt + r]; } }
        scan_step<1>(av, bv); scan_step<2>(av, bv); scan_step<4>(av, bv); scan_step<8>(av, bv);
        LAS float* ag = agg + (c & 1) * 1024;
        if (fr == 15) {
#pragma unroll
            for (int g = 0; g < 4; ++g) { LAS float* p = ag + (w * 64 + 16 * g + 4 * fq) * 2;
                *(LAS f32x4*)p = (f32x4){av[4 * g], bv[4 * g], av[4 * g + 1], bv[4 * g + 1]}; *(LAS f32x4*)(p + 4) = (f32x4){av[4 * g + 2], bv[4 * g + 2], av[4 * g + 3], bv[4 * g + 3]}; }
        }
        LDS_BARRIER();
        float hin[16];
#pragma unroll
        for (int i = 0; i < 16; ++i) hin[i] = 0.f;
#pragma unroll
        for (int w2 = 0; w2 < 8; ++w2) {
            if (w2 == w) {
#pragma unroll
                for (int i = 0; i < 16; ++i) hin[i] = hc[i]; }
#pragma unroll
            for (int g = 0; g < 4; ++g) { const LAS float* p = ag + (w2 * 64 + 16 * g + 4 * fq) * 2; const f32x4 q0 = *(const LAS f32x4*)p, q1 = *(const LAS f32x4*)(p + 4);
                hc[4 * g] = q0.x * hc[4 * g] + q0.y; hc[4 * g + 1] = q0.z * hc[4 * g + 1] + q0.w; hc[4 * g + 2] = q1.x * hc[4 * g + 2] + q1.y; hc[4 * g + 3] = q1.z * hc[4 * g + 3] + q1.w; }
        }
#pragma unroll
        for (int g = 0; g < 4; ++g) { float y[4];
#pragma unroll
            for (int r = 0; r < 4; ++r) { const int i = 4 * g + r; const float hv = bv[i] + av[i] * hin[i];
                const float gt = (r & 1) ? bfhi(r < 2 ? graw[g].x : graw[g].y) : bflo(r < 2 ? graw[g].x : graw[g].y);
                const float inner = 1.5957691216057308f * (gt + 0.044715f * gt * gt * gt);
                y[r] = hv * gt * fsigmoid(inner); }
            *(v2u*)(py + (size_t)t * DM + 16 * g) = (v2u){pk2(y[0], y[1]), pk2(y[2], y[3])}; }
    }
}

__device__ __forceinline__ int crow(int i, int hh) { return (i & 3) + 8 * (i >> 2) + 4 * hh; }
constexpr int AK_PITCH = 272, AV_PITCH = 80, AK_BYTES = 32 * AK_PITCH, AV_BYTES = 128 * AV_PITCH, A_FLAGS = 4 * AK_BYTES + 4 * AV_BYTES;
constexpr float SB_DONE = 1e-36f;
__device__ __forceinline__ void att_compute(LAS unsigned char* lds, int cur, int hsel, int qi, int hh, int tq, int kt, bool diag, const bf16x8 (&qf)[8], f32x16 (&o)[4], float& carry) {
    const LAS unsigned char* kb_ = lds + (cur * 2 + hsel) * AK_BYTES; const LAS unsigned char* vb_ = lds + 4 * AK_BYTES + (cur * 2 + hsel) * AV_BYTES;
    const int key0 = 32 * kt;
    f32x16 s;
#pragma unroll
    for (int i = 0; i < 16; ++i) s[i] = 0.f;
    asm volatile("" : "+v"(s));
#pragma unroll
    for (int ks = 0; ks < 8; ++ks) { const bf16x8 kf = *(const LAS bf16x8*)(kb_ + qi * AK_PITCH + 32 * ks + 16 * hh);
        s = __builtin_amdgcn_mfma_f32_32x32x16_bf16(kf, qf[ks], s, 0, 0, 0); }
    float nb[16], be[16];
#pragma unroll
    for (int i = 0; i < 16; ++i) { const float z = s[i]; const float t = __builtin_amdgcn_exp2f(-fabsf(z)); const float r = __builtin_amdgcn_rcpf(1.f + t); const float tr = t * r;
        const bool pos = z >= 0.f; be[i] = pos ? r : tr; nb[i] = pos ? tr : r; }
    if (diag) {
#pragma unroll
        for (int i = 0; i < 16; ++i) { const bool valid = key0 + crow(i, hh) < tq; be[i] = valid ? be[i] : 0.f; nb[i] = valid ? nb[i] : 1.f; } }
    float so[4], sp[4], tot[4];
#pragma unroll
    for (int g = 0; g < 4; ++g) { so[g] = (nb[4 * g] * nb[4 * g + 1]) * (nb[4 * g + 2] * nb[4 * g + 3]); sp[g] = __shfl_xor(so[g], 32); tot[g] = so[g] * sp[g]; }
    float after[4];
    after[3] = (hh == 0) ? sp[3] : 1.f;
    after[2] = tot[3] * ((hh == 0) ? sp[2] : 1.f);
    after[1] = (tot[3] * tot[2]) * ((hh == 0) ? sp[1] : 1.f);
    after[0] = ((tot[3] * tot[2]) * tot[1]) * ((hh == 0) ? sp[0] : 1.f);
    float wv[16];
#pragma unroll
    for (int g = 0; g < 4; ++g) { const float x3 = carry * after[g], x2 = x3 * nb[4 * g + 3], x1 = x2 * nb[4 * g + 2], x0 = x1 * nb[4 * g + 1];
        wv[4 * g + 3] = be[4 * g + 3] * x3; wv[4 * g + 2] = be[4 * g + 2] * x2; wv[4 * g + 1] = be[4 * g + 1] * x1; wv[4 * g] = be[4 * g] * x0; }
    carry *= (tot[0] * tot[1]) * (tot[2] * tot[3]);
    const bf16x8 pa0 = __builtin_bit_cast(bf16x8, (v4u){pk2(wv[0], wv[1]), pk2(wv[2], wv[3]), pk2(wv[4], wv[5]), pk2(wv[6], wv[7])});
    const bf16x8 pa1 = __builtin_bit_cast(bf16x8, (v4u){pk2(wv[8], wv[9]), pk2(wv[10], wv[11]), pk2(wv[12], wv[13]), pk2(wv[14], wv[15])});
#pragma unroll
    for (int dt = 0; dt < 4; ++dt) { const LAS unsigned char* vp = vb_ + (32 * dt + qi) * AV_PITCH + 16 * hh;
        const bf16x8 v0 = *(const LAS bf16x8*)vp, v1 = *(const LAS bf16x8*)(vp + 32);
        o[dt] = __builtin_amdgcn_mfma_f32_32x32x16_bf16(v0, pa0, o[dt], 0, 0, 0); o[dt] = __builtin_amdgcn_mfma_f32_32x32x16_bf16(v1, pa1, o[dt], 0, 0, 0); }
}
__device__ __forceinline__ void attn_unit(const bf16* Q, const bf16* K, const bf16* Vt, bf16* Y, int unit, LAS unsigned char* lds, int tid) {
    const int qb = unit & 31, hp = (unit >> 5) & 7, b = unit >> 8;
    const int lane = tid & 63, w = __builtin_amdgcn_readfirstlane(tid >> 6), qi = lane & 31, hh = lane >> 5;
    const int hsel = w >> 2, wl = w & 3, h = 2 * hp + hsel;
    const int q0 = qb * 128, tq = q0 + 32 * wl + qi;
    LAS int* flags = (LAS int*)(lds + A_FLAGS);
    __syncthreads();
    if (tid < 16) flags[tid] = 0;
    bf16x8 qf[8];
    { const bf16* qp = Q + (size_t)(b * SEQ + tq) * DM + h * 128 + 8 * hh;
#pragma unroll
      for (int ks = 0; ks < 8; ++ks) qf[ks] = *(const bf16x8*)(qp + 16 * ks); }
    f32x16 o[4];
#pragma unroll
    for (int dt = 0; dt < 4; ++dt)
#pragma unroll
        for (int i = 0; i < 16; ++i) o[dt][i] = 0.f;
#pragma unroll
    for (int dt = 0; dt < 4; ++dt) asm volatile("" : "+v"(o[dt]));
    float carry = 1.f; bool done = false;
    const int ktop = 4 * qb + 3, ktw = 4 * qb + wl;
    const int kkey = tid >> 4, kc = tid & 15;
    const int vd = tid >> 2, vc4 = tid & 3;
    const bf16* kg = K + (size_t)(b * SEQ + kkey) * DM + (2 * hp) * 128 + 8 * kc;
    const bf16* vg = Vt + ((size_t)((b * 16 + 2 * hp) * 128 + vd) << 12) + 8 * vc4;
    const int kdst = kkey * AK_PITCH + 16 * kc;
    const int vdst = vd * AV_PITCH + 2 * (16 * (vc4 >> 1) + 4 * (vc4 & 1));
    v4u kr[2], vr[2];
#define A_LOAD(kt) do { _Pragma("unroll") for (int i_ = 0; i_ < 2; ++i_) { kr[i_] = *(const v4u*)(kg + i_ * 128 + (size_t)(32 * (kt)) * DM); vr[i_] = *(const v4u*)(vg + ((size_t)(128 * i_) << 12) + 32 * (kt)); } } while (0)
#define A_WRITE(bufi) do { _Pragma("unroll") for (int i_ = 0; i_ < 2; ++i_) { *(LAS v4u*)(lds + ((bufi) * 2 + i_) * AK_BYTES + kdst) = kr[i_]; \
        LAS unsigned char* vp_ = lds + 4 * AK_BYTES + ((bufi) * 2 + i_) * AV_BYTES + vdst; *(LAS v2u*)vp_ = (v2u){vr[i_].x, vr[i_].y}; *(LAS v2u*)(vp_ + 16) = (v2u){vr[i_].z, vr[i_].w}; } } while (0)
    A_LOAD(ktop); A_WRITE(0);
    if (ktop > 0) A_LOAD(ktop - 1);
    v4u kr2[2], vr2[2];
#pragma unroll
    for (int i_ = 0; i_ < 2; ++i_) { kr2[i_] = kr[i_]; vr2[i_] = vr[i_]; }
    int it = 0, kt = ktop; bool fin = false;
#define ATT_STEP(KW, VW, KL, VL) do { \
        const int cur = it & 1; \
        if (kt > 1) { _Pragma("unroll") for (int i_ = 0; i_ < 2; ++i_) { KL[i_] = *(const v4u*)(kg + i_ * 128 + (size_t)(32 * (kt - 2)) * DM); VL[i_] = *(const v4u*)(vg + ((size_t)(128 * i_) << 12) + 32 * (kt - 2)); } } \
        LDS_BARRIER(); \
        if (it > 0) { const LAS int* f = flags + ((it - 1) & 1) * 8; int all = 1; _Pragma("unroll") for (int i = 0; i < 8; ++i) all &= f[i]; if (all) { fin = true; break; } } \
        if (!done && kt <= ktw) { att_compute(lds, cur, hsel, qi, hh, tq, kt, kt == ktw, qf, o, carry); done = (__builtin_amdgcn_ballot_w64(carry >= SB_DONE) == 0ull); } \
        if (lane == 0) flags[cur * 8 + w] = done ? 1 : 0; \
        if (kt == 0) { fin = true; break; } \
        _Pragma("unroll") for (int i_ = 0; i_ < 2; ++i_) { *(LAS v4u*)(lds + ((cur ^ 1) * 2 + i_) * AK_BYTES + kdst) = KW[i_]; \
            LAS unsigned char* vp_ = lds + 4 * AK_BYTES + ((cur ^ 1) * 2 + i_) * AV_BYTES + vdst; *(LAS v2u*)vp_ = (v2u){VW[i_].x, VW[i_].y}; *(LAS v2u*)(vp_ + 16) = (v2u){VW[i_].z, VW[i_].w}; } \
        ++it; --kt; } while (0)
    while (!fin) { ATT_STEP(kr, vr, kr2, vr2); if (fin) break; ATT_STEP(kr2, vr2, kr, vr); }
#undef ATT_STEP
#undef A_LOAD
#undef A_WRITE
    bf16* yp = Y + (size_t)(b * SEQ + tq) * DM + h * 128 + 4 * hh;
#pragma unroll
    for (int dt = 0; dt < 4; ++dt)
#pragma unroll
        for (int g = 0; g < 4; ++g) *(v2u*)(yp + 32 * dt + 8 * g) = (v2u){pk2(o[dt][4 * g], o[dt][4 * g + 1]), pk2(o[dt][4 * g + 2], o[dt][4 * g + 3])};
}

#define XB_TMO      128
#define XB_XCNT(j)  (256  + 64 * (j))
#define XB_XSUB(j)  (1280 + 64 * (j))
#define XB_XGEN(j)  (2304 + 64 * (j))
#define XB_TOP      3328
#define XB_TOPGEN   3392
#define XCD_BAR_WORDS 3456
#define XB_SPIN_CAP (1u << 18)

__device__ __forceinline__ unsigned xb_ld(unsigned* p)              { return __hip_atomic_load(p, __ATOMIC_RELAXED, __HIP_MEMORY_SCOPE_AGENT); }
__device__ __forceinline__ unsigned xb_add(unsigned* p, unsigned v) { return __hip_atomic_fetch_add(p, v, __ATOMIC_RELAXED, __HIP_MEMORY_SCOPE_AGENT); }
__device__ __forceinline__ unsigned xb_xcc_id() { return (unsigned)__builtin_amdgcn_s_getreg((3 << 11) | 20) & 0xFu; }
#define XB_SPIN(cond, bar) do { unsigned _sp = 0; while (cond) { __builtin_amdgcn_s_sleep(1); \
    if ((++_sp & 255u) == 0u) { if (xb_ld(&(bar)[XB_TMO])) break; if (_sp > XB_SPIN_CAP) { atomicAdd(&(bar)[XB_TMO], 1u); break; } } } } while (0)

struct XcdBarrier {
    unsigned* bar; unsigned x;
    volatile LAS unsigned* st;
};

__device__ __forceinline__ XcdBarrier xcd_barrier_post(unsigned* bar, volatile LAS unsigned* st) {
    XcdBarrier b; b.bar = bar; b.x = xb_xcc_id(); b.st = st;
    if (threadIdx.x == 0) (void)xb_add(&bar[XB_XCNT(b.x)], 1u);
    return b;
}
__device__ __forceinline__ void xcd_barrier_complete(unsigned* bar, unsigned x, unsigned& nloc, unsigned& nx) {
    const unsigned G = gridDim.x * gridDim.y * gridDim.z;
    unsigned sum, cnt, mine, sp = 0u;
    for (;;) {
        sum = 0u; cnt = 0u; mine = 0u;
#pragma unroll
        for (unsigned j = 0; j < 16; ++j) { const unsigned c = xb_ld(&bar[XB_XCNT(j)]); sum += c; cnt += (c > 0u) ? 1u : 0u; mine = (j == x) ? c : mine; }
        if (sum == G) break;
        __builtin_amdgcn_s_sleep(1);
        if ((++sp & 255u) == 0u) { if (xb_ld(&bar[XB_TMO])) break; if (sp > XB_SPIN_CAP) { atomicAdd(&bar[XB_TMO], 1u); break; } }
    }
    nloc = mine > 0u ? mine : 1u; nx = cnt > 0u ? cnt : 1u;
}

__device__ __forceinline__ void xcd_barrier(const XcdBarrier& b) {
    asm volatile("s_waitcnt vmcnt(0)" ::: "memory");
    __syncthreads();
    if (threadIdx.x == 0) {
        unsigned* bar = b.bar;
        __builtin_amdgcn_s_waitcnt(0);
        unsigned nloc = b.st[0], nx = b.st[1];
        if (nloc == 0u) { xcd_barrier_complete(bar, b.x, nloc, nx); b.st[0] = nloc; b.st[1] = nx; }
        const unsigned old = xb_add(&bar[XB_XSUB(b.x)], 1u);
        const unsigned gen = old / nloc;
        if (old + 1u == (gen + 1u) * nloc) {
            __builtin_amdgcn_fence(__ATOMIC_RELEASE, "agent");
            asm volatile("s_waitcnt vmcnt(0)" ::: "memory");
            const unsigned og = xb_add(&bar[XB_TOP], 1u);
            const unsigned tg = og / nx;
            if (og + 1u == (tg + 1u) * nx) xb_add(&bar[XB_TOPGEN], 1u);
            else XB_SPIN(xb_ld(&bar[XB_TOPGEN]) == tg, bar);
            __builtin_amdgcn_fence(__ATOMIC_ACQUIRE, "agent");
            xb_add(&bar[XB_XGEN(b.x)], 1u);
            asm volatile("s_waitcnt vmcnt(0)" ::: "memory");
        } else {
            XB_SPIN(xb_ld(&bar[XB_XGEN(b.x)]) == gen, bar);
            __builtin_amdgcn_fence(__ATOMIC_ACQUIRE, "agent");
            asm volatile("s_waitcnt vmcnt(0)" ::: "memory");
        }
    }
    __syncthreads();
}

struct Args { const float* in[16]; float* out; unsigned char* ws; };
__global__ void __launch_bounds__(NTHR, 2) mega_fwd(Args args) {
    extern __shared__ __attribute__((aligned(16))) unsigned char lds_raw[];
    LAS unsigned char* lds = (LAS unsigned char*)lds_raw;
    cg::grid_group grid = cg::this_grid();
    if (threadIdx.x < 64) ((LAS unsigned*)(lds + LDS_MISC))[threadIdx.x] = 0u;
    __syncthreads();
    const XcdBarrier bar = xcd_barrier_post((unsigned*)(args.ws + WS_CTL), (volatile LAS unsigned*)(lds + LDS_MISC) + 8);
    const int G = gridDim.x, bx = blockIdx.x, NGW = G * NWAVES;
    unsigned char* ws = args.ws;
    const float* x = args.in[0]; const float* gains = args.in[1];
    bf16* Wt_in = (bf16*)(ws + WS_WIN); bf16* Wt_out = (bf16*)(ws + WS_WOUT); bf16* Wt_qkv = (bf16*)(ws + WS_WQKV); bf16* Wt_o = (bf16*)(ws + WS_WO);
    bf16* XR = (bf16*)(ws + WS_H); bf16* MIX = (bf16*)(ws + WS_MIX); bf16* BIG = (bf16*)(ws + WS_BIG); float* RS = (float*)(ws + WS_RS);
    float* out = args.out; bf16* Yb = (bf16*)args.out;

    bf16* Qb = BIG; bf16* Kb = BIG + (size_t)MTOK * DM; bf16* Vtb = BIG + 2 * (size_t)MTOK * DM;
    for (int ph = 0; ph < 15; ++ph) {
        int tid = threadIdx.x; asm volatile("" : "+v"(tid));
        const int lane = tid & 63, wave = __builtin_amdgcn_readfirstlane(tid >> 6), gw = bx * NWAVES + wave;
        const int layer = ph >= 8 ? 1 : 0;
        const float* g = gains + (size_t)layer * 4 * DM;
        int gk = -1;
        if (ph == 1 || ph == 3 || ph == 5 || ph == 6 || ph == 8 || ph == 10 || ph == 12 || ph == 13) gk = ph;
        if (gk >= 0) {
#ifndef NO_GEMM
            pg8::Gemm gm{XR, Wt_in, MTOK, DIN, DM}; pg8::EpiGen E{0, BIG, DIN, Kb, Vtb, 0.08838834764831845f * 1.4426950408889634f, RS};
            if (gk == 3) { gm.A = Yb; gm.Bt = Wt_out; gm.N = DM; E.O = MIX; E.ldc = DM; E.rowscale = nullptr; }
            else if (gk == 5 || gk == 12) { gm.Bt = (const bf16*)(ws + (gk == 12 ? WS_WUP1 : WS_WUP0)); gm.N = DFF; E.mode = 2; E.ldc = DFF; }
            else if (gk == 6 || gk == 13) { gm.A = BIG; gm.Bt = (const bf16*)(ws + (gk == 13 ? WS_WDN1 : WS_WDN0)); gm.N = DM; gm.K = DFF; E.O = MIX; E.ldc = DM; E.rowscale = nullptr; }
            else if (gk == 8) { gm.Bt = Wt_qkv; gm.N = NQKV; E.mode = 3; E.O = Qb; E.ldc = DM; }
            else if (gk == 10) { gm.A = Yb; gm.Bt = Wt_o; gm.N = DM; E.O = MIX; E.ldc = DM; E.rowscale = nullptr; }
            pg8::StaticOrder S; S.init(MTOK, gm.N, G, bx);
            pg8::gemm_phase<pg8::EpiGen, pg8::StaticOrder, true, true>(lds, gm, S, E);
#endif
        } else if (ph == 0) {
#ifndef NO_P0
            LAS float* scr = (LAS float*)(lds + wave * 16384);
            constexpr int I_IN = 32 * 160;
            for (int it = gw; it < I_IN; it += NGW) p0_transpose_item(args.in[2], DM, DIN, Wt_in, scr, it, lane, gains);
            cvt_rows(x, XR, RS, gw, NGW, lane);
#endif
        } else if (ph == 2) {
#ifndef NO_MIX
            constexpr int NB = BATCH * 16, NA = MTOK / 64;
            for (int it = bx; it < NB + NA; it += G) {
                if (it < NB) mixerB_item(BIG, args.in[4], args.in[5], args.in[6], args.in[7], args.in[8], args.in[9], args.in[10], Yb, it, lds, tid);
                else mixerA_item(BIG, args.in[3], Yb, it - NB, tid);
            }
            {
                const int first = (G > NB) ? NB : 0;
                if (bx >= first) {
                    __syncthreads();
                    LAS float* scr = (LAS float*)(lds + wave * 16384);
                    constexpr int I_OUT = 32 * 64, I_QKV = 32 * 192, I_O = 32 * 64, I_UP = 32 * 256, I_DN = 128 * 64;
                    const int gw2 = (bx - first) * NWAVES + wave, NGW2 = (G - first) * NWAVES;
                    for (int it = gw2; it < I_OUT + I_QKV + I_O + 2 * I_UP + 2 * I_DN; it += NGW2) {
                        int r = it;
                        if (r < I_OUT) { p0_transpose_item(args.in[11], DM, DM, Wt_out, scr, r, lane); continue; } r -= I_OUT;
                        if (r < I_UP) { p0_transpose_item(args.in[14], DM, DFF, (bf16*)(ws + WS_WUP0), scr, r, lane, gains + 2 * DM); continue; } r -= I_UP;
                        if (r < I_DN) { p0_transpose_item(args.in[15], DFF, DM, (bf16*)(ws + WS_WDN0), scr, r, lane); continue; } r -= I_DN;
                        if (r < I_QKV) { p0_transpose_item(args.in[12], DM, NQKV, Wt_qkv, scr, r, lane, gains + 4 * DM); continue; } r -= I_QKV;
                        if (r < I_O) { p0_transpose_item(args.in[13], DM, DM, Wt_o, scr, r, lane); continue; } r -= I_O;
                        if (r < I_UP) { p0_transpose_item(args.in[14] + (size_t)DM * DFF, DM, DFF, (bf16*)(ws + WS_WUP1), scr, r, lane, gains + 6 * DM); continue; } r -= I_UP;
                        p0_transpose_item(args.in[15] + (size_t)DFF * DM, DFF, DM, (bf16*)(ws + WS_WDN1), scr, r, lane);
                    }
                }
            }
#endif
        } else if (ph == 9) {
#ifndef NO_ATTN
            if (G == 256) { for (int k = 0; k < 8; ++k) attn_unit(Qb, Kb, Vtb, Yb, (((k << 3) | (bx & 7)) << 5) | (bx >> 3), lds, tid); }
            else { for (int u = bx; u < BATCH * 8 * 32; u += G) attn_unit(Qb, Kb, Vtb, Yb, u, lds, tid); }
#endif
        } else {
#ifndef NO_POST
            const float* gpost = (ph == 4 || ph == 11) ? g + DM : g + 3 * DM;
            if (ph == 14) post_rows<true>(MIX, XR, out, gpost, RS, gw, NGW, lane); else post_rows<false>(MIX, XR, out, gpost, RS, gw, NGW, lane);
#endif
        }
        if (ph == 0) grid.sync(); else if (ph < 14) xcd_barrier(bar);
    }
}

extern "C" void kernel_launch(void* const* d_in, const int* in_sizes, int n_in, void* d_out, int out_size, void* d_ws, size_t ws_size, hipStream_t stream) {
    static int grid = 0;
    if (grid == 0) {
        if (n_in != 16 || in_sizes[0] != MTOK * DM || out_size != MTOK * DM || ws_size < WS_END) { fprintf(stderr, "kernel_launch: unexpected shapes / workspace (n_in %d, ws %zu); nothing launched\n", n_in, ws_size); grid = -1; return; }
        int dev = 0, cus = 0, per_cu = 0;
        if (hipGetDevice(&dev) != hipSuccess || hipDeviceGetAttribute(&cus, hipDeviceAttributeMultiprocessorCount, dev) != hipSuccess) { grid = -1; return; }
        if (hipFuncSetAttribute((const void*)mega_fwd, hipFuncAttributeMaxDynamicSharedMemorySize, LDS_BYTES) != hipSuccess) { fprintf(stderr, "kernel_launch: hipFuncSetAttribute failed\n"); grid = -1; return; }
        if (hipOccupancyMaxActiveBlocksPerMultiprocessor(&per_cu, (const void*)mega_fwd, NTHR, LDS_BYTES) != hipSuccess || per_cu < 1) { fprintf(stderr, "kernel_launch: occupancy query says %d\n", per_cu); per_cu = 1; }
        (void)hipGetLastError();
        grid = cus;
    }
    if (grid < 0) return;
    if (hipMemsetAsync((char*)d_ws + WS_CTL, 0, CTL_BYTES, stream) != hipSuccess) { fprintf(stderr, "kernel_launch: memset of the barrier words failed\n"); return; }
    Args a{};
    for (int i = 0; i < 16; ++i) a.in[i] = (const float*)d_in[i];
    a.out = (float*)d_out; a.ws = (unsigned char*)d_ws;
    void* kargs[] = {&a};
    hipError_t e = hipLaunchCooperativeKernel((const void*)mega_fwd, dim3(grid), dim3(NTHR), kargs, LDS_BYTES, stream);
    if (e != hipSuccess) fprintf(stderr, "kernel_launch: cooperative launch failed: %s (grid %d)\n", hipGetErrorString(e), grid);
}
```
